# Optimizing an MI355X kernel written in HIP

```python
import math
import jax, jax.numpy as jnp
from jax import lax
import numpy as np

D_MODEL = 1024
BATCH = 8
SEQ = 4096
DEPTH = 2

HEAD_DIM = 64
MOBA_HEADS = (D_MODEL // 2) // HEAD_DIM
MOBA_BLOCK = 256
MOBA_TOPK = 3
MOBA_QCHUNK = 32
DIFF_QK_DIM = HEAD_DIM
DIFF_V_DIM = 2 * DIFF_QK_DIM
DIFF_HEADS = (D_MODEL // 2) // DIFF_V_DIM
DIFF_QBLOCK = 128
D_FF = ((8 * D_MODEL // 3 + 127) // 128) * 128
RMS_EPS = 1e-6
MOBA_W = MOBA_HEADS * HEAD_DIM
DIFF_QK_W = DIFF_HEADS * 2 * DIFF_QK_DIM
DIFF_V_W = DIFF_HEADS * DIFF_V_DIM
MIX_W = MOBA_W + DIFF_V_W
IN_W = 3 * MOBA_W + 2 * DIFF_QK_W + DIFF_V_W
SPLITS = tuple(np.cumsum([MOBA_W, MOBA_W, MOBA_W, DIFF_QK_W, DIFF_QK_W]).tolist())

kernel_name = "hymba_moba_diffattn_macaron_sandwich"


def alibi_slopes(n):
    return jnp.asarray(2.0 ** (-8.0 * np.arange(1, n + 1) / n), dtype=jnp.float32)


def rmsnorm(x, g):
    xf = x.astype(jnp.float32)
    y = xf * lax.rsqrt(jnp.mean(xf * xf, axis=-1, keepdims=True) + RMS_EPS)
    return (y * g.astype(jnp.float32)).astype(x.dtype)


def swiglu(h, w_gate, w_up, w_down):
    return (jax.nn.silu(h @ w_gate) * (h @ w_up)) @ w_down


def moba_attention(q, k, v, slopes):
    B, H, S, dh = q.shape
    nb = -(-S // MOBA_BLOCK)
    sp = nb * MOBA_BLOCK
    pad = sp - S
    if pad:
        q, k, v = [jnp.pad(t, ((0, 0), (0, 0), (0, pad), (0, 0))) for t in (q, k, v)]
    kb = k.reshape(B, H, nb, MOBA_BLOCK, dh)
    vb = v.reshape(B, H, nb, MOBA_BLOCK, dh)
    kmean = jnp.mean(kb.astype(jnp.float32), axis=3)
    ksel = min(MOBA_TOPK, nb)
    scale = dh ** -0.5
    nch = sp // MOBA_QCHUNK
    qc = q.reshape(B, H, nch, MOBA_QCHUNK, dh).transpose(2, 0, 1, 3, 4)
    gather = jax.vmap(jax.vmap(lambda blocks, idx: blocks[idx]))
    offs = jnp.arange(MOBA_BLOCK)
    blk_ids = jnp.arange(nb)
    sel_ids = jnp.arange(ksel)

    def chunk(args):
        ci, qq = args
        qpos = ci * MOBA_QCHUNK + jnp.arange(MOBA_QCHUNK)
        cur = (ci * MOBA_QCHUNK) // MOBA_BLOCK
        qf = qq.astype(jnp.float32)
        gate = jnp.einsum('bhqd,bhnd->bhqn', qf, kmean)
        gate = jnp.where(blk_ids < cur, gate, -jnp.inf)
        _, idx = lax.top_k(gate, ksel)
        valid = sel_ids < cur
        k_sel = gather(kb, idx).astype(jnp.float32)
        v_sel = gather(vb, idx).astype(jnp.float32)
        s_sel = jnp.einsum('bhqd,bhqjkd->bhqjk', qf, k_sel) * scale
        kpos_sel = idx[..., None] * MOBA_BLOCK + offs
        s_sel = s_sel - slopes[:, None, None, None] * (qpos[:, None, None] - kpos_sel)
        s_sel = jnp.where(valid[:, None], s_sel, -jnp.inf)
        s_sel = s_sel.reshape(B, H, MOBA_QCHUNK, ksel * MOBA_BLOCK)
        k_own = lax.dynamic_slice_in_dim(kb, cur, 1, axis=2)[:, :, 0].astype(jnp.float32)
        v_own = lax.dynamic_slice_in_dim(vb, cur, 1, axis=2)[:, :, 0].astype(jnp.float32)
        kpos_own = cur * MOBA_BLOCK + offs
        dist = qpos[:, None] - kpos_own[None, :]
        s_own = jnp.einsum('bhqd,bhkd->bhqk', qf, k_own) * scale - slopes[:, None, None] * dist
        s_own = jnp.where(dist >= 0, s_own, -jnp.inf)
        p = jax.nn.softmax(jnp.concatenate([s_sel, s_own], axis=-1), axis=-1)
        p_sel = p[..., :ksel * MOBA_BLOCK].reshape(B, H, MOBA_QCHUNK, ksel, MOBA_BLOCK)
        p_own = p[..., ksel * MOBA_BLOCK:]
        o = (jnp.einsum('bhqjk,bhqjkd->bhqd', p_sel, v_sel)
             + jnp.einsum('bhqk,bhkd->bhqd', p_own, v_own))
        return o.astype(q.dtype)

    out = lax.map(chunk, (jnp.arange(nch), qc))
    out = out.transpose(1, 2, 0, 3, 4).reshape(B, H, sp, dh)
    return out[:, :, :S]


def diff_attention(q, k, v, lam, lam_init, subln_g, slopes):
    B, H, _, S, d = q.shape
    nqb = S // DIFF_QBLOCK
    scale = d ** -0.5
    qb = q.reshape(B, H, 2, nqb, DIFF_QBLOCK, d).transpose(3, 0, 1, 2, 4, 5)
    kf = k.astype(jnp.float32)
    vf = v.astype(jnp.float32)
    kpos = jnp.arange(S)

    def blk(args):
        bi, qq = args
        qpos = bi * DIFF_QBLOCK + jnp.arange(DIFF_QBLOCK)
        dist = qpos[:, None] - kpos[None, :]
        s = jnp.einsum('bhmqd,bhmkd->bhmqk', qq.astype(jnp.float32), kf) * scale
        s = s - slopes[:, None, None, None] * dist
        s = jnp.where(dist >= 0, s, -jnp.inf)
        p = jax.nn.softmax(s, axis=-1)
        a = p[:, :, 0] - lam * p[:, :, 1]
        return jnp.einsum('bhqk,bhkd->bhqd', a, vf)

    out = lax.map(blk, (jnp.arange(nqb), qb))
    out = out.transpose(1, 2, 0, 3, 4).reshape(B, H, S, 2 * d)
    out = rmsnorm(out, subln_g) * (1.0 - lam_init)
    return out.astype(q.dtype)


def setup_inputs(seed: int = 0) -> dict:
    key = jax.random.key(seed)
    ks = jax.random.split(key, 24)
    L = DEPTH

    def w(k, shape, fan_in):
        return jax.random.normal(k, shape, jnp.float32) * (fan_in ** -0.5)

    def gain(k, shape):
        return 1.0 + 0.02 * jax.random.normal(k, shape, jnp.float32)

    return {
        "x": jax.random.normal(ks[0], (BATCH, SEQ, D_MODEL), jnp.float32),
        "ffn1_pre_g": gain(ks[1], (L, D_MODEL)),
        "ffn1_w_gate": w(ks[2], (L, D_MODEL, D_FF), D_MODEL),
        "ffn1_w_up": w(ks[3], (L, D_MODEL, D_FF), D_MODEL),
        "ffn1_w_down": w(ks[4], (L, D_FF, D_MODEL), D_FF),
        "ffn1_post_g": gain(ks[5], (L, D_MODEL)),
        "mix_pre_g": gain(ks[6], (L, D_MODEL)),
        "w_in": w(ks[7], (L, D_MODEL, IN_W), D_MODEL),
        "lambda_q1": 0.1 * jax.random.normal(ks[8], (L, DIFF_QK_DIM), jnp.float32),
        "lambda_k1": 0.1 * jax.random.normal(ks[9], (L, DIFF_QK_DIM), jnp.float32),
        "lambda_q2": 0.1 * jax.random.normal(ks[10], (L, DIFF_QK_DIM), jnp.float32),
        "lambda_k2": 0.1 * jax.random.normal(ks[11], (L, DIFF_QK_DIM), jnp.float32),
        "subln_g": gain(ks[12], (L, DIFF_V_DIM)),
        "w_out": w(ks[13], (L, MIX_W, D_MODEL), MIX_W),
        "mix_post_g": gain(ks[14], (L, D_MODEL)),
        "ffn2_pre_g": gain(ks[15], (L, D_MODEL)),
        "ffn2_w_gate": w(ks[16], (L, D_MODEL, D_FF), D_MODEL),
        "ffn2_w_up": w(ks[17], (L, D_MODEL, D_FF), D_MODEL),
        "ffn2_w_down": w(ks[18], (L, D_FF, D_MODEL), D_FF),
        "ffn2_post_g": gain(ks[19], (L, D_MODEL)),
    }


def reference(x, ffn1_pre_g, ffn1_w_gate, ffn1_w_up, ffn1_w_down, ffn1_post_g,
              mix_pre_g, w_in, lambda_q1, lambda_k1, lambda_q2, lambda_k2, subln_g,
              w_out, mix_post_g, ffn2_pre_g, ffn2_w_gate, ffn2_w_up, ffn2_w_down, ffn2_post_g):
    B, S, _ = x.shape
    slopes_moba = alibi_slopes(MOBA_HEADS)
    slopes_diff = alibi_slopes(DIFF_HEADS)
    for l in range(DEPTH):
        h = rmsnorm(x, ffn1_pre_g[l])
        x = x + 0.5 * rmsnorm(swiglu(h, ffn1_w_gate[l], ffn1_w_up[l], ffn1_w_down[l]), ffn1_post_g[l])

        h = rmsnorm(x, mix_pre_g[l])
        proj = h @ w_in[l]
        q_m, k_m, v_m, q_d, k_d, v_d = jnp.split(proj, SPLITS, axis=-1)
        to_heads = lambda t: t.reshape(B, S, MOBA_HEADS, HEAD_DIM).transpose(0, 2, 1, 3)
        o_m = moba_attention(to_heads(q_m), to_heads(k_m), to_heads(v_m), slopes_moba)
        o_m = o_m.transpose(0, 2, 1, 3).reshape(B, S, MOBA_W)

        to_pairs = lambda t: t.reshape(B, S, DIFF_HEADS, 2, DIFF_QK_DIM).transpose(0, 2, 3, 1, 4)
        v_dh = v_d.reshape(B, S, DIFF_HEADS, DIFF_V_DIM).transpose(0, 2, 1, 3)
        lam_init = 0.8 - 0.6 * math.exp(-0.3 * l)
        lam = (jnp.exp(jnp.sum(lambda_q1[l].astype(jnp.float32) * lambda_k1[l].astype(jnp.float32)))
               - jnp.exp(jnp.sum(lambda_q2[l].astype(jnp.float32) * lambda_k2[l].astype(jnp.float32)))
               + lam_init)
        o_d = diff_attention(to_pairs(q_d), to_pairs(k_d), v_dh, lam, lam_init, subln_g[l], slopes_diff)
        o_d = o_d.transpose(0, 2, 1, 3).reshape(B, S, DIFF_V_W)

        mix = jnp.concatenate([o_m, o_d], axis=-1)
        x = x + rmsnorm(mix @ w_out[l], mix_post_g[l])

        h = rmsnorm(x, ffn2_pre_g[l])
        x = x + 0.5 * rmsnorm(swiglu(h, ffn2_w_gate[l], ffn2_w_up[l], ffn2_w_down[l]), ffn2_post_g[l])
    return x
```

```cpp
#include <hip/hip_runtime.h>
#include <cstdio>
#include <cstdint>
#include <cmath>
#ifndef N_LAUNCH_MODE
#define N_LAUNCH_MODE 0
#endif
#ifndef REF_ATTN
#define REF_ATTN 1
#endif
namespace pg8 {
#define PG8_LAS __attribute__((address_space(3)))
typedef unsigned short bf16_t;
typedef short bf16x8 __attribute__((ext_vector_type(8)));
typedef float f32x4 __attribute__((ext_vector_type(4)));
typedef unsigned u32x4 __attribute__((ext_vector_type(4)));
constexpr int BM = 256, BK = 64, HALF = 128, HTB = HALF * BK * 2  , STAGE_BYTES = 8 * HTB, NXCD = 8, WGM = 8;

__host__ __device__ __forceinline__ int lds_byte(int r, int c) { const int st = (r >> 4) * 2 + (c >> 5), rr = r & 15, cc = c & 31, ob = rr * 64 + cc * 2; return st * 1024 + (ob ^ (((ob >> 9) & 1) << 5)); }
__host__ __device__ __forceinline__ void stage_rc(int b, int& R, int& C) { const int st = b / 1024, sb = b % 1024, swz = sb ^ (((sb >> 9) & 1) << 5); R = (st >> 1) * 16 + swz / 64; C = (st & 1) * 32 + (swz % 64) / 2; }
__host__ __device__ __forceinline__ int perm32(int rho) { const int n = rho >> 4, i = rho & 15; return 8 * (i >> 2) + 4 * n + (i & 3); }

struct Unit { int pm, pn; };
struct Gemm { const bf16_t* A; const bf16_t* Bt; int M, N, K; };

struct StaticOrder {
    int nM, nN, nwg, G, c;
    __host__ __device__ void init(int M, int N, int G_, int c_) { nM = M / BM; nN = N / BM; nwg = nM * nN; G = G_; c = c_; }
    __host__ __device__ bool next(int i, Unit& u) const {
        const long L = (long)i * G + c; if (L >= nwg) return false;
        int wgid = (int)L; { const int q = nwg / NXCD, r = nwg % NXCD, xcd = wgid % NXCD, off = wgid / NXCD; wgid = (xcd < r ? xcd * (q + 1) : r * (q + 1) + (xcd - r) * q) + off; }
        const int nig = WGM * nN, gid = wgid / nig, fm = gid * WGM, gsz = (nM - fm) < WGM ? (nM - fm) : WGM;
        u.pm = fm + ((wgid % nig) % gsz); u.pn = (wgid % nig) / gsz; return true;
    }
    __device__ __forceinline__ void a_ready(const Unit&) const {}
    __device__ __forceinline__ void done(const Unit&) const {}
};

__device__ __forceinline__ unsigned cvt_pk_bf16(float lo, float hi) { unsigned r; asm volatile("v_cvt_pk_bf16_f32 %0, %1, %2" : "=v"(r) : "v"(lo), "v"(hi)); return r; }
typedef float f32x2 __attribute__((ext_vector_type(2)));

struct EpiF32 {
    static constexpr bool PERM = false, AFTER_DRAIN = false;
    float* C; int ldc;
    __device__ __forceinline__ void operator()(const f32x4 (&acc)[2][2][4][2], const Unit& u, int wr, int wc, int fr, int fq) const {
        const int row0 = u.pm * BM + wr * 64 + fr, col0 = u.pn * BM + wc * 32 + 4 * fq;
#pragma unroll
        for (int ai = 0; ai < 2; ++ai)
#pragma unroll
            for (int m = 0; m < 4; ++m) { float* rowp = C + (size_t)(row0 + ai * HALF + m * 16) * ldc + col0;
#pragma unroll
                for (int bj = 0; bj < 2; ++bj)
#pragma unroll
                    for (int n = 0; n < 2; ++n) *(f32x4*)(rowp + bj * HALF + n * 16) = acc[ai][bj][m][n]; }
    }
};
struct EpiProj {
    static constexpr bool PERM = true, AFTER_DRAIN = false;
    bf16_t* O; int ldc; unsigned qmask; float qscale;
    __device__ __forceinline__ void operator()(const f32x4 (&acc)[2][2][4][2], const Unit& u, int wr, int wc, int fr, int fq) const {
        const int row0 = u.pm * BM + wr * 64 + fr; const int col0 = u.pn * BM + wc * 32 + 8 * fq;
        const float sc = ((qmask >> u.pn) & 1u) ? qscale : 1.f;
#pragma unroll
        for (int ai = 0; ai < 2; ++ai)
#pragma unroll
            for (int m = 0; m < 4; ++m) { bf16_t* rowp = O + (size_t)(row0 + ai * HALF + m * 16) * ldc + col0;
#pragma unroll
                for (int bj = 0; bj < 2; ++bj) { const f32x4 v0 = acc[ai][bj][m][0] * sc, v1 = acc[ai][bj][m][1] * sc;
                    u32x4 w; w.x = cvt_pk_bf16(v0[0], v0[1]); w.y = cvt_pk_bf16(v0[2], v0[3]); w.z = cvt_pk_bf16(v1[0], v1[1]); w.w = cvt_pk_bf16(v1[2], v1[3]);
                    *(u32x4*)(rowp + bj * HALF) = w; } }
    }
};
__device__ __forceinline__ float silu_mul(float g, float u) { const float e = __builtin_amdgcn_exp2f(g * -1.4426950408889634f); return g * __builtin_amdgcn_rcpf(1.0f + e) * u; }
struct EpiSwiGLU {
    static constexpr bool PERM = true, AFTER_DRAIN = false;
    bf16_t* O; int ldc;
    __device__ __forceinline__ void operator()(const f32x4 (&acc)[2][2][4][2], const Unit& u, int wr, int wc, int fr, int fq) const {
        const int row0 = u.pm * BM + wr * 64 + fr; const int col0 = u.pn * HALF + wc * 32 + 8 * fq;
#pragma unroll
        for (int ai = 0; ai < 2; ++ai)
#pragma unroll
            for (int m = 0; m < 4; ++m) { bf16_t* rowp = O + (size_t)(row0 + ai * HALF + m * 16) * ldc + col0;
                const f32x4 g0 = acc[ai][0][m][0], g1 = acc[ai][0][m][1], u0 = acc[ai][1][m][0], u1 = acc[ai][1][m][1];
                u32x4 w;
                w.x = cvt_pk_bf16(silu_mul(g0[0], u0[0]), silu_mul(g0[1], u0[1])); w.y = cvt_pk_bf16(silu_mul(g0[2], u0[2]), silu_mul(g0[3], u0[3]));
                w.z = cvt_pk_bf16(silu_mul(g1[0], u1[0]), silu_mul(g1[1], u1[1])); w.w = cvt_pk_bf16(silu_mul(g1[2], u1[2]), silu_mul(g1[3], u1[3]));
                *(u32x4*)rowp = w; }
    }
};

template <class Epi, class Sched, bool ALIGN_EPI = false, bool SP2 = false>
__device__ __forceinline__ void gemm_phase(PG8_LAS unsigned char* lds, const Gemm g, const Sched& S, const Epi& E) {
    int tid_l = threadIdx.x; asm volatile("" : "+v"(tid_l));
    const int tid = tid_l, wid = __builtin_amdgcn_readfirstlane(tid >> 6), lane = tid & 63, wr = wid >> 2, wc = wid & 3, fr = lane & 15, fq = lane >> 4;
    const int K = g.K, nt = K / BK;
    unsigned voffA[2], voffB[2];
#pragma unroll
    for (int i = 0; i < 2; ++i) { int R, C; stage_rc(tid * 16 + i * 8192, R, C); const int Rb = Epi::PERM ? ((R & ~31) + perm32(R & 31)) : R;
        voffA[i] = (unsigned)(R * K + C) * 2u; voffB[i] = (unsigned)(Rb * K + C) * 2u; }
    const size_t kstep = (size_t)(BK * 2);
    const size_t hstep = (size_t)HALF * K * 2;
    const size_t tstep = 2 * hstep;
    const unsigned ldsw = (unsigned)wid * 1024u;
    const int aoff = lds_byte(wr * 64 + fr, fq * 8), boff = lds_byte(wc * 32 + fr, fq * 8);
#define PG8_SA(b, h) (((b) * 2 + (h)) * HTB)
#define PG8_SB(b, h) ((4 + (b) * 2 + (h)) * HTB)
#define PG8_STAGE(bufoff, gbase, voff) do { _Pragma("unroll") for (int _i = 0; _i < 2; ++_i) \
        __builtin_amdgcn_global_load_lds((const unsigned*)((const char*)(gbase) + (voff)[_i]), (PG8_LAS unsigned*)(lds + (bufoff) + ldsw + _i * 8192), 16, 0, 0); } while (0)
#define PG8_LDA(dst, b, h) do { _Pragma("unroll") for (int m = 0; m < 4; ++m) _Pragma("unroll") for (int k = 0; k < 2; ++k) dst[m][k] = *(const PG8_LAS bf16x8*)(lds + PG8_SA(b, h) + aoff + m * 2048 + k * 1024); } while (0)
#define PG8_LDB(dst, b, h) do { _Pragma("unroll") for (int n = 0; n < 2; ++n) _Pragma("unroll") for (int k = 0; k < 2; ++k) dst[n][k] = *(const PG8_LAS bf16x8*)(lds + PG8_SB(b, h) + boff + n * 2048 + k * 1024); } while (0)
#define PG8_MMA(ai, bj, At, Bt) do { __builtin_amdgcn_s_setprio(1); _Pragma("unroll") for (int m = 0; m < 4; ++m) _Pragma("unroll") for (int n = 0; n < 2; ++n) _Pragma("unroll") for (int k = 0; k < 2; ++k) \
        acc[ai][bj][m][n] = __builtin_amdgcn_mfma_f32_16x16x32_bf16(Bt[n][k], At[m][k], acc[ai][bj][m][n], 0, 0, 0); __builtin_amdgcn_s_setprio(0); } while (0)
#define PG8_WAIT_V(n) asm volatile("s_waitcnt vmcnt(" #n ")" ::: "memory")
#define PG8_WAIT_L(n) asm volatile("s_waitcnt lgkmcnt(" #n ")" ::: "memory")
#define PG8_BAR __builtin_amdgcn_s_barrier()
#define PG8_SCHED __builtin_amdgcn_sched_barrier(0)
    Unit cur, nxt; int ui = 0;
    if (!S.next(0, cur)) return;
    f32x4 acc[2][2][4][2];
#pragma unroll
    for (int a = 0; a < 2; ++a)
#pragma unroll
        for (int b = 0; b < 2; ++b)
#pragma unroll
            for (int m = 0; m < 4; ++m)
#pragma unroll
                for (int n = 0; n < 2; ++n) acc[a][b][m][n] = (f32x4){0.f, 0.f, 0.f, 0.f};
    bf16x8 At[4][2], B0[2][2], B1[2][2];
    const char* cA = (const char*)g.A + (size_t)cur.pm * tstep; const char* cB = (const char*)g.Bt + (size_t)cur.pn * tstep;
    S.a_ready(cur);
    if constexpr (SP2) {
        PG8_STAGE(PG8_SB(0, 0), cB, voffB); PG8_STAGE(PG8_SB(0, 1), cB + hstep, voffB); PG8_STAGE(PG8_SA(0, 0), cA, voffA); PG8_STAGE(PG8_SA(0, 1), cA + hstep, voffA);
        if (wr == 1) PG8_BAR;
        PG8_WAIT_V(2); PG8_BAR;
        PG8_STAGE(PG8_SB(1, 0), cB + kstep, voffB); PG8_STAGE(PG8_SA(1, 0), cA + kstep, voffA); PG8_STAGE(PG8_SB(1, 1), cB + hstep + kstep, voffB);
        PG8_WAIT_V(6); PG8_BAR;
    } else {
        PG8_STAGE(PG8_SB(0, 0), cB, voffB); PG8_STAGE(PG8_SA(0, 0), cA, voffA); PG8_STAGE(PG8_SB(0, 1), cB + hstep, voffB); PG8_STAGE(PG8_SA(0, 1), cA + hstep, voffA);
        if (wr == 1) PG8_BAR;
        PG8_WAIT_V(4); PG8_BAR;
        PG8_STAGE(PG8_SB(1, 0), cB + kstep, voffB); PG8_STAGE(PG8_SA(1, 0), cA + kstep, voffA); PG8_STAGE(PG8_SB(1, 1), cB + hstep + kstep, voffB);
        PG8_WAIT_V(6); PG8_BAR;
    }
    for (;;) {
        const bool has_next = S.next(ui + 1, nxt);
        const char* nA = has_next ? (const char*)g.A + (size_t)nxt.pm * tstep : cA; const char* nB = has_next ? (const char*)g.Bt + (size_t)nxt.pn * tstep : cB;
        for (int t = 0; t < nt; t += 2) {
            const bool last = (t == nt - 2);
            const char* a1 = cA + (size_t)(t + 1) * kstep;
            const char* a2 = last ? nA : cA + (size_t)(t + 2) * kstep; const char* b2 = last ? nB : cB + (size_t)(t + 2) * kstep;
            const char* a3 = a2 + kstep; const char* b3 = b2 + kstep;
            if (last && has_next) S.a_ready(nxt);
            if constexpr (SP2) {
            PG8_LDB(B0, 0, 0); PG8_LDB(B1, 0, 1); PG8_SCHED; PG8_LDA(At, 0, 0); PG8_STAGE(PG8_SA(1, 1), a1 + hstep, voffA);
            PG8_WAIT_V(8); PG8_WAIT_L(0); PG8_BAR; PG8_MMA(0, 0, At, B0); PG8_MMA(0, 1, At, B1); PG8_BAR; PG8_SCHED;
            PG8_LDA(At, 0, 1); PG8_STAGE(PG8_SB(0, 0), b2, voffB); PG8_STAGE(PG8_SB(0, 1), b2 + hstep, voffB); PG8_STAGE(PG8_SA(0, 0), a2, voffA);
            PG8_WAIT_V(8); PG8_WAIT_L(0); PG8_BAR; PG8_MMA(1, 0, At, B0); PG8_MMA(1, 1, At, B1); PG8_BAR; PG8_SCHED;
            PG8_LDB(B0, 1, 0); PG8_LDB(B1, 1, 1); PG8_SCHED; PG8_LDA(At, 1, 0); PG8_STAGE(PG8_SA(0, 1), a2 + hstep, voffA);
            PG8_WAIT_V(8); PG8_WAIT_L(0); PG8_BAR; PG8_MMA(0, 0, At, B0); PG8_MMA(0, 1, At, B1); PG8_BAR; PG8_SCHED;
            PG8_LDA(At, 1, 1); PG8_STAGE(PG8_SB(1, 0), b3, voffB); PG8_STAGE(PG8_SB(1, 1), b3 + hstep, voffB); PG8_STAGE(PG8_SA(1, 0), a3, voffA);
            PG8_WAIT_V(8); PG8_WAIT_L(0); PG8_BAR; PG8_MMA(1, 0, At, B0); PG8_MMA(1, 1, At, B1); PG8_BAR; PG8_SCHED;
            } else {
            PG8_LDB(B0, 0, 0); PG8_SCHED; PG8_LDA(At, 0, 0); PG8_STAGE(PG8_SA(1, 1), a1 + hstep, voffA);
            PG8_WAIT_L(8); PG8_BAR; PG8_WAIT_L(0); PG8_MMA(0, 0, At, B0); PG8_BAR; PG8_SCHED;
            PG8_LDB(B1, 0, 1); PG8_STAGE(PG8_SB(0, 0), b2, voffB);
            PG8_BAR; PG8_WAIT_L(0); PG8_MMA(0, 1, At, B1); PG8_BAR;
            PG8_LDA(At, 0, 1); PG8_STAGE(PG8_SA(0, 0), a2, voffA);
            PG8_BAR; PG8_WAIT_L(0); PG8_MMA(1, 0, At, B0); PG8_BAR; PG8_SCHED;
            PG8_STAGE(PG8_SB(0, 1), b2 + hstep, voffB);
            PG8_WAIT_V(6); PG8_BAR; PG8_MMA(1, 1, At, B1); PG8_BAR;
            PG8_LDB(B0, 1, 0); PG8_SCHED; PG8_LDA(At, 1, 0); PG8_STAGE(PG8_SA(0, 1), a2 + hstep, voffA);
            PG8_WAIT_L(8); PG8_BAR; PG8_WAIT_L(0); PG8_MMA(0, 0, At, B0); PG8_BAR; PG8_SCHED;
            PG8_LDB(B1, 1, 1); PG8_STAGE(PG8_SB(1, 0), b3, voffB);
            PG8_BAR; PG8_WAIT_L(0); PG8_MMA(0, 1, At, B1); PG8_BAR;
            PG8_LDA(At, 1, 1); PG8_STAGE(PG8_SA(1, 0), a3, voffA);
            PG8_BAR; PG8_WAIT_L(0); PG8_MMA(1, 0, At, B0); PG8_BAR; PG8_SCHED;
            PG8_STAGE(PG8_SB(1, 1), b3 + hstep, voffB);
            PG8_WAIT_V(6); PG8_BAR; PG8_MMA(1, 1, At, B1); PG8_BAR;
            }
        }
        if constexpr (ALIGN_EPI) { if (wr == 0) PG8_BAR; }
        if constexpr (!Epi::AFTER_DRAIN) { E(acc, cur, wr, wc, fr, fq); S.done(cur); }
        if (!has_next) break;
#pragma unroll
        for (int a = 0; a < 2; ++a)
#pragma unroll
            for (int b = 0; b < 2; ++b)
#pragma unroll
                for (int m = 0; m < 4; ++m)
#pragma unroll
                    for (int n = 0; n < 2; ++n) acc[a][b][m][n] = (f32x4){0.f, 0.f, 0.f, 0.f};
        cur = nxt; cA = nA; cB = nB; ++ui;
        if constexpr (ALIGN_EPI) { if (wr == 1) PG8_BAR; }
    }
    PG8_WAIT_V(0);
    if constexpr (!ALIGN_EPI) { if (wr == 0) PG8_BAR; }
    PG8_BAR;
    if constexpr (Epi::AFTER_DRAIN) { E.fused(acc, cur, wr, wc, fr, fq, lds, wid, lane); S.done(cur); }
#undef PG8_SA
#undef PG8_SB
#undef PG8_STAGE
#undef PG8_LDA
#undef PG8_LDB
#undef PG8_MMA
#undef PG8_WAIT_V
#undef PG8_WAIT_L
#undef PG8_BAR
#undef PG8_SCHED
}
}
#define GAS __attribute__((address_space(1)))
#define LAS __attribute__((address_space(3)))
typedef unsigned short bf16;
typedef unsigned v4u __attribute__((ext_vector_type(4)));
typedef float f32x4 __attribute__((ext_vector_type(4)));
typedef short bf16x8 __attribute__((ext_vector_type(8)));
typedef GAS unsigned gu32;
typedef GAS unsigned long long gu64;
#define RLX_AGENT __ATOMIC_RELAXED, __HIP_MEMORY_SCOPE_AGENT
#define LDS_WAIT() asm volatile("s_waitcnt lgkmcnt(0)" ::: "memory")
#define VM_WAIT() asm volatile("s_waitcnt vmcnt(0)" ::: "memory")
__device__ __forceinline__ unsigned long long rt() { return __builtin_amdgcn_s_memrealtime(); }
__device__ __forceinline__ unsigned f2bf(float f) { unsigned u = __builtin_bit_cast(unsigned, f); return (u + 0x7fffu + ((u >> 16) & 1u)) >> 16; }
__device__ __forceinline__ unsigned pk2(float lo, float hi) { return f2bf(lo) | (f2bf(hi) << 16); }

#define XB_TMO      128
#define XB_XCNT(j)  (256  + 64 * (j))
#define XB_XSUB(j)  (1280 + 64 * (j))
#define XB_XGEN(j)  (2304 + 64 * (j))
#define XB_TOP      3328
#define XB_TOPGEN   3392
#define XCD_BAR_WORDS 3456
#define XB_SPIN_CAP (1u << 18)

__device__ __forceinline__ unsigned xb_ld(unsigned* p)              { return __hip_atomic_load(p, __ATOMIC_RELAXED, __HIP_MEMORY_SCOPE_AGENT); }
__device__ __forceinline__ unsigned xb_add(unsigned* p, unsigned v) { return __hip_atomic_fetch_add(p, v, __ATOMIC_RELAXED, __HIP_MEMORY_SCOPE_AGENT); }
__device__ __forceinline__ unsigned xb_xcc_id() { return (unsigned)__builtin_amdgcn_s_getreg((3 << 11) | 20) & 0xFu; }
#define XB_SPIN(cond, bar) do { unsigned _sp = 0; while (cond) { __builtin_amdgcn_s_sleep(1); \
    if ((++_sp & 255u) == 0u) { if (xb_ld(&(bar)[XB_TMO])) break; if (_sp > XB_SPIN_CAP) { atomicAdd(&(bar)[XB_TMO], 1u); break; } } } } while (0)

struct XcdBarrier {
    unsigned* bar; unsigned x;
    volatile LAS unsigned* st;
};

__device__ __forceinline__ XcdBarrier xcd_barrier_post(unsigned* bar, volatile LAS unsigned* st) {
    XcdBarrier b; b.bar = bar; b.x = xb_xcc_id(); b.st = st;
    if (threadIdx.x == 0) (void)xb_add(&bar[XB_XCNT(b.x)], 1u);
    return b;
}
__device__ __forceinline__ void xcd_barrier_complete(unsigned* bar, unsigned x, unsigned& nloc, unsigned& nx) {
    const unsigned G = gridDim.x * gridDim.y * gridDim.z;
    unsigned sum, cnt, mine, sp = 0u;
    for (;;) {
        sum = 0u; cnt = 0u; mine = 0u;
#pragma unroll
        for (unsigned j = 0; j < 16; ++j) { const unsigned c = xb_ld(&bar[XB_XCNT(j)]); sum += c; cnt += (c > 0u) ? 1u : 0u; mine = (j == x) ? c : mine; }
        if (sum == G) break;
        __builtin_amdgcn_s_sleep(1);
        if ((++sp & 255u) == 0u) { if (xb_ld(&bar[XB_TMO])) break; if (sp > XB_SPIN_CAP) { atomicAdd(&bar[XB_TMO], 1u); break; } }
    }
    nloc = mine > 0u ? mine : 1u; nx = cnt > 0u ? cnt : 1u;
}

__device__ __forceinline__ void xcd_barrier(const XcdBarrier& b) {
    asm volatile("s_waitcnt vmcnt(0)" ::: "memory");
    __syncthreads();
    if (threadIdx.x == 0) {
        unsigned* bar = b.bar;
        __builtin_amdgcn_s_waitcnt(0);
        unsigned nloc = b.st[0], nx = b.st[1];
        if (nloc == 0u) { xcd_barrier_complete(bar, b.x, nloc, nx); b.st[0] = nloc; b.st[1] = nx; }
        const unsigned old = xb_add(&bar[XB_XSUB(b.x)], 1u);
        const unsigned gen = old / nloc;
        if (old + 1u == (gen + 1u) * nloc) {
            __builtin_amdgcn_fence(__ATOMIC_RELEASE, "agent");
            asm volatile("s_waitcnt vmcnt(0)" ::: "memory");
            const unsigned og = xb_add(&bar[XB_TOP], 1u);
            const unsigned tg = og / nx;
            if (og + 1u == (tg + 1u) * nx) xb_add(&bar[XB_TOPGEN], 1u);
            else XB_SPIN(xb_ld(&bar[XB_TOPGEN]) == tg, bar);
            __builtin_amdgcn_fence(__ATOMIC_ACQUIRE, "agent");
            xb_add(&bar[XB_XGEN(b.x)], 1u);
            asm volatile("s_waitcnt vmcnt(0)" ::: "memory");
        } else {
            XB_SPIN(xb_ld(&bar[XB_XGEN(b.x)]) == gen, bar);
            __builtin_amdgcn_fence(__ATOMIC_ACQUIRE, "agent");
            asm volatile("s_waitcnt vmcnt(0)" ::: "memory");
        }
    }
    __syncthreads();
}

constexpr int BATCH = 8, SEQ = 4096, DM = 1024, DEPTH = 2, FF = 2816, NGU = 2 * FF, INW = 3072;
constexpr int M = BATCH * SEQ;
constexpr int NHM = 8, NHD = 4;
constexpr int MIXW = 1024, DW = 512;
constexpr float RMS_EPS = 1e-6f;
constexpr float LOG2E = 1.4426950408889634f;
constexpr float C2 = 0.125f * LOG2E;
constexpr int PC_QM = 0, PC_KM = 512, PC_VM = 1024, PC_QD = 1536, PC_KD = 2048, PC_VD = 2560;
constexpr int PH_PER_LAYER = 13, NPHASE = 1 + DEPTH * PH_PER_LAYER;

constexpr size_t MiB = 1u << 20;
constexpr size_t WS_CTL = 0, CTL_ZERO_BYTES = 1 * MiB;
constexpr size_t WS_KMEAN = 1 * MiB;
constexpr size_t WS_SEL = 2 * MiB;
constexpr size_t WS_W = 4 * MiB, W_LAYER = 41 * MiB;
constexpr size_t W_GU1 = 0, W_DN1 = 11 * MiB, W_IN = W_DN1 + 11 * MiB / 2, W_OUT = W_IN + 6 * MiB, W_GU2 = W_OUT + 2 * MiB, W_DN2 = W_GU2 + 11 * MiB;
static_assert(W_DN2 + 11 * MiB / 2 == W_LAYER, "weight map");
constexpr size_t WS_H = 88 * MiB;
constexpr size_t WS_Y = 152 * MiB;
constexpr size_t WS_BIG = 280 * MiB;
constexpr size_t WS_END = 472 * MiB;
static_assert(WS_W + DEPTH * W_LAYER <= WS_H && WS_H + (size_t)M * DM * 2 <= WS_Y && WS_Y + (size_t)M * DM * 4 <= WS_BIG && WS_BIG + (size_t)M * INW * 2 <= WS_END, "d_ws map");
constexpr int CW_TMO = 0, CW_CODE = 1, CW_BAR = 4096;

constexpr int RING_OFF = 0, SCRATCH_BYTES = 153600;
constexpr int LDSCTL_OFF = SCRATCH_BYTES, MISC_OFF = LDSCTL_OFF + 320;
constexpr int LDS_BYTES = 155648;
static_assert(MISC_OFF + 128 <= LDS_BYTES, "LDS map");
constexpr int NWAVES = 8;

__device__ __forceinline__ float bf2f(unsigned u) { return __uint_as_float(u << 16); }
__device__ __forceinline__ float wave_sum(float v) {
#pragma unroll
    for (int o = 1; o < 64; o <<= 1) v += __shfl_xor(v, o);
    return v;
}
__device__ __forceinline__ float dot4(f32x4 a, f32x4 b) { return (a.x * b.x + a.y * b.y) + (a.z * b.z + a.w * b.w); }

__device__ __forceinline__ void transpose_item(const float* W, int K, int N, bf16* WT, int kb, int nb, int dstrow0, LAS float* scr, int lane) {
    const int k0 = 64 * kb, n0 = 32 * nb;
#pragma unroll 8
    for (int i = 0; i < 32; ++i) { const int kk = 2 * i + (lane >> 5); scr[kk * 33 + (lane & 31)] = W[(size_t)(k0 + kk) * N + n0 + (lane & 31)]; }
    LDS_WAIT(); asm volatile("" ::: "memory");
    const int c = lane & 7;
#pragma unroll
    for (int j = 0; j < 4; ++j) { const int n = (lane >> 3) + 8 * j; const LAS float* s = scr + (8 * c) * 33 + n;
        v4u o; o.x = pk2(s[0 * 33], s[1 * 33]); o.y = pk2(s[2 * 33], s[3 * 33]); o.z = pk2(s[4 * 33], s[5 * 33]); o.w = pk2(s[6 * 33], s[7 * 33]);
        *(GAS v4u*)(WT + (size_t)(dstrow0 + n0 + n) * K + k0 + 8 * c) = o; }
    LDS_WAIT(); asm volatile("" ::: "memory");
}
__device__ __forceinline__ void rms_row_to_bf16(const float* xrow, const float* g, bf16* orow, int lane) {
    const GAS f32x4* xr = (const GAS f32x4*)xrow + lane; const GAS f32x4* gr = (const GAS f32x4*)g + lane;
    f32x4 v[4]; float s = 0.f;
#pragma unroll
    for (int j = 0; j < 4; ++j) { v[j] = xr[64 * j]; s += dot4(v[j], v[j]); }
    const float r = 1.f / sqrtf(wave_sum(s) * (1.f / DM) + RMS_EPS);
    GAS unsigned long long* o8 = (GAS unsigned long long*)orow + lane;
#pragma unroll
    for (int j = 0; j < 4; ++j) { const f32x4 gg = gr[64 * j]; const f32x4 h = v[j] * gg * r;
        o8[64 * j] = (unsigned long long)pk2(h.x, h.y) | ((unsigned long long)pk2(h.z, h.w) << 32); }
}
struct Args { const float* in[20]; float* out; unsigned char* ws; int ph_lo, ph_hi, li, pad; };
constexpr int ITEMS_FFW = 16 * 88, ITEMS_DNW = 44 * 32, ITEMS_INW = 16 * 96, ITEMS_OUTW = 16 * 32;
constexpr int ITEMS_LAYER = 4 * ITEMS_FFW + 2 * ITEMS_DNW + ITEMS_INW + ITEMS_OUTW;
typedef const __attribute__((address_space(4))) Args* kargs_t0;
__device__ __forceinline__ void prologue_phase(kargs_t0 Pq, LAS unsigned char* lds, int gw, int NGW, int wave, int lane) {
    LAS float* scr = (LAS float*)(lds + RING_OFF + wave * 16384);
    for (int it = gw; it < DEPTH * ITEMS_LAYER; it += NGW) {
        const int l = it / ITEMS_LAYER; int r = it % ITEMS_LAYER;
        unsigned char* wl = Pq->ws + WS_W + (size_t)l * W_LAYER;
        const size_t offF = (size_t)l * DM * FF, offI = (size_t)l * DM * INW, offO = (size_t)l * DM * DM;
        if (r < 2 * ITEMS_FFW) { const int up = r >= ITEMS_FFW; if (up) r -= ITEMS_FFW; const int kb = r / 88, nb = r % 88, n0 = 32 * nb;
            transpose_item((up ? Pq->in[3] : Pq->in[2]) + offF, DM, FF, (bf16*)(wl + W_GU1), kb, nb, 256 * (n0 >> 7) + (n0 & 127) + up * 128 - n0, scr, lane); continue; }
        r -= 2 * ITEMS_FFW;
        if (r < ITEMS_DNW) { transpose_item(Pq->in[4] + offF, FF, DM, (bf16*)(wl + W_DN1), r / 32, r % 32, 0, scr, lane); continue; }
        r -= ITEMS_DNW;
        if (r < ITEMS_INW) { transpose_item(Pq->in[7] + offI, DM, INW, (bf16*)(wl + W_IN), r / 96, r % 96, 0, scr, lane); continue; }
        r -= ITEMS_INW;
        if (r < ITEMS_OUTW) { transpose_item(Pq->in[13] + offO, DM, DM, (bf16*)(wl + W_OUT), r / 32, r % 32, 0, scr, lane); continue; }
        r -= ITEMS_OUTW;
        if (r < 2 * ITEMS_FFW) { const int up = r >= ITEMS_FFW; if (up) r -= ITEMS_FFW; const int kb = r / 88, nb = r % 88, n0 = 32 * nb;
            transpose_item((up ? Pq->in[17] : Pq->in[16]) + offF, DM, FF, (bf16*)(wl + W_GU2), kb, nb, 256 * (n0 >> 7) + (n0 & 127) + up * 128 - n0, scr, lane); continue; }
        r -= 2 * ITEMS_FFW;
        transpose_item(Pq->in[18] + offF, FF, DM, (bf16*)(wl + W_DN2), r / 32, r % 32, 0, scr, lane);
    }
    bf16* H = (bf16*)(Pq->ws + WS_H);
    for (int m = gw; m < M; m += NGW) rms_row_to_bf16(Pq->in[0] + (size_t)m * DM, Pq->in[1], H + (size_t)m * DM, lane);
}
__device__ __forceinline__ void ew_phase(const float* xsrc, const float* Y, float* xdst, float coef, const float* gpost, const float* gnext, bf16* H, int gw, int NGW, int lane) {
    for (int r = gw; r < M; r += NGW) {
        const GAS f32x4* xr = (const GAS f32x4*)(xsrc + (size_t)r * DM) + lane; const GAS f32x4* yr = (const GAS f32x4*)(Y + (size_t)r * DM) + lane;
        const GAS f32x4* g1 = (const GAS f32x4*)gpost + lane;
        f32x4 xv[4], yv[4]; float s = 0.f;
#pragma unroll
        for (int j = 0; j < 4; ++j) { yv[j] = yr[64 * j]; xv[j] = xr[64 * j]; s += dot4(yv[j], yv[j]); }
        const float r1 = coef / sqrtf(wave_sum(s) * (1.f / DM) + RMS_EPS);
        float s2 = 0.f; GAS f32x4* xo = (GAS f32x4*)(xdst + (size_t)r * DM) + lane;
#pragma unroll
        for (int j = 0; j < 4; ++j) { xv[j] = xv[j] + yv[j] * g1[64 * j] * r1; s2 += dot4(xv[j], xv[j]); xo[64 * j] = xv[j]; }
        if (gnext) {
            const float r2 = 1.f / sqrtf(wave_sum(s2) * (1.f / DM) + RMS_EPS);
            const GAS f32x4* g2 = (const GAS f32x4*)gnext + lane; GAS unsigned long long* o8 = (GAS unsigned long long*)(H + (size_t)r * DM) + lane;
#pragma unroll
            for (int j = 0; j < 4; ++j) { const f32x4 h = xv[j] * g2[64 * j] * r2; o8[64 * j] = (unsigned long long)pk2(h.x, h.y) | ((unsigned long long)pk2(h.z, h.w) << 32); }
        }
    }
}
__device__ __forceinline__ void kmean_phase(const bf16* proj, float* kmean, LAS float* scr, int vcu, int G, int tid) {
    for (int it = vcu; it < BATCH * 16; it += G) {
        const int b = it >> 4, blk = it & 15, cp = tid & 255, rh = tid >> 8;
        const bf16* p = proj + ((size_t)b * SEQ + blk * 256 + rh * 128) * INW + PC_KM + cp * 2;
        float s0 = 0.f, s1 = 0.f;
#pragma unroll 8
        for (int i = 0; i < 128; ++i) { const unsigned w = *(const GAS unsigned*)(p + (size_t)i * INW); s0 += bf2f(w & 0xffffu); s1 += bf2f(w >> 16); }
        if (rh == 1) { scr[cp * 2] = s0; scr[cp * 2 + 1] = s1; }
        __syncthreads();
        if (rh == 0) { s0 += scr[cp * 2]; s1 += scr[cp * 2 + 1]; const int col = cp * 2, h = col >> 6, d = col & 63;
            float* o = kmean + ((size_t)((b * NHM + h) * 16 + blk)) * 64 + d; o[0] = s0 * (1.f / 256.f); o[1] = s1 * (1.f / 256.f); }
        __syncthreads();
    }
}
__device__ __forceinline__ void gate_phase(const bf16* proj, const float* kmean, unsigned* sel, int vcu, int G, int tid) {
    for (int idx = vcu * 512 + tid; idx < M * NHM; idx += G * 512) {
        const int t = idx >> 3, h = idx & 7, b = t >> 12, c = (t & 4095) >> 8;
        unsigned mask;
        if (c <= 3) mask = (1u << c) - 1u;
        else {
            f32x4 q[16];
            const GAS v4u* qp = (const GAS v4u*)(proj + (size_t)t * INW + PC_QM + h * 64);
#pragma unroll
            for (int i = 0; i < 8; ++i) { const v4u w = qp[i]; q[2 * i] = (f32x4){bf2f(w.x & 0xffffu), bf2f(w.x >> 16), bf2f(w.y & 0xffffu), bf2f(w.y >> 16)};
                q[2 * i + 1] = (f32x4){bf2f(w.z & 0xffffu), bf2f(w.z >> 16), bf2f(w.w & 0xffffu), bf2f(w.w >> 16)}; }
            const GAS f32x4* km = (const GAS f32x4*)(kmean + (size_t)(b * NHM + h) * 16 * 64);
            float v0 = -INFINITY, v1 = -INFINITY, v2 = -INFINITY; int i0 = 0, i1 = 0, i2 = 0;
#pragma unroll 1
            for (int j = 0; j < c; ++j) { float s = 0.f;
#pragma unroll
                for (int i = 0; i < 16; ++i) s += dot4(q[i], km[j * 16 + i]);
                if (s > v0) { v2 = v1; i2 = i1; v1 = v0; i1 = i0; v0 = s; i0 = j; }
                else if (s > v1) { v2 = v1; i2 = i1; v1 = s; i1 = j; }
                else if (s > v2) { v2 = s; i2 = j; } }
            mask = (1u << i0) | (1u << i1) | (1u << i2);
        }
        sel[idx] = mask;
    }
}
__device__ __forceinline__ void diffnorm_phase(const float* Dbuf, const float* subg, float osc, bf16* mix, int gw, int NGW, int lane) {
    for (int r = gw; r < M; r += NGW) {
        const GAS f32x4* dr = (const GAS f32x4*)(Dbuf + (size_t)r * DW) + lane;
        const f32x4 a = dr[0], b = dr[64];
        float sa = dot4(a, a), sb = dot4(b, b);
#pragma unroll
        for (int o = 1; o < 32; o <<= 1) { sa += __shfl_xor(sa, o); sb += __shfl_xor(sb, o); }
        const float ra = osc / sqrtf(sa * (1.f / 128.f) + RMS_EPS), rb = osc / sqrtf(sb * (1.f / 128.f) + RMS_EPS);
        const f32x4 g = ((const GAS f32x4*)subg)[lane & 31];
        const f32x4 oa = a * g * ra, ob = b * g * rb;
        GAS unsigned long long* o8 = (GAS unsigned long long*)(mix + (size_t)r * MIXW + DW) + lane;
        o8[0] = (unsigned long long)pk2(oa.x, oa.y) | ((unsigned long long)pk2(oa.z, oa.w) << 32);
        o8[64] = (unsigned long long)pk2(ob.x, ob.y) | ((unsigned long long)pk2(ob.z, ob.w) << 32);
    }
}
__device__ __forceinline__ float lam_init_of(int l) { return l == 0 ? 0.2f : 0.35550907f; }

#if REF_ATTN
__global__ void __launch_bounds__(256) ref_moba(const bf16* proj, const unsigned* sel, bf16* mix) {
    __shared__ float Ks[64][64], Vs[64][64];
    const int bid = blockIdx.x, c = bid & 15, h = (bid >> 4) & 7, b = bid >> 7, tid = threadIdx.x;
    const int qpos = c * 256 + tid; const size_t row = (size_t)b * SEQ + qpos;
    float q[64], o[64];
#pragma unroll
    for (int d = 0; d < 64; ++d) { q[d] = bf2f(proj[row * INW + PC_QM + h * 64 + d]); o[d] = 0.f; }
    const unsigned smask = sel[row * NHM + h];
    const float slope2 = exp2f(-(float)(h + 1)) * LOG2E;
    float m = -INFINITY, l = 0.f;
    for (int j = c; j >= 0; --j) {
        const bool act = (j == c) || ((smask >> j) & 1u);
        for (int kt = 3; kt >= 0; --kt) {
            __syncthreads();
            { const int r = tid >> 2, qd = tid & 3; const bf16* kp = proj + ((size_t)b * SEQ + j * 256 + kt * 64 + r) * INW + h * 64 + qd * 16;
#pragma unroll
              for (int i = 0; i < 16; ++i) { Ks[r][qd * 16 + i] = bf2f(kp[PC_KM + i]); Vs[r][qd * 16 + i] = bf2f(kp[PC_VM + i]); } }
            __syncthreads();
            if (act) for (int k = 63; k >= 0; --k) { const int kpos = j * 256 + kt * 64 + k; if (kpos > qpos) continue;
                float s = 0.f;
#pragma unroll
                for (int d = 0; d < 64; ++d) s += q[d] * Ks[k][d];
                s += slope2 * (float)(kpos - qpos);
                if (s > m) { const float a = exp2f(m - s); l *= a;
#pragma unroll
                    for (int d = 0; d < 64; ++d) o[d] *= a;
                    m = s; }
                const float p = exp2f(s - m); l += p;
#pragma unroll
                for (int d = 0; d < 64; ++d) o[d] += p * Vs[k][d]; }
        }
    }
    const float il = 1.f / l;
#pragma unroll
    for (int d = 0; d < 64; ++d) mix[row * MIXW + h * 64 + d] = (bf16)f2bf(o[d] * il);
}
__global__ void __launch_bounds__(256) ref_diff(const bf16* proj, const float* lq1, const float* lk1, const float* lq2, const float* lk2, float lam_init, float* Dbuf) {
    __shared__ float Ks[64][64], Vs[64][64];
    const int bid = blockIdx.x, c = bid & 15, vh = (bid >> 4) & 1, hd = (bid >> 5) & 3, b = bid >> 7, tid = threadIdx.x;
    const int qpos = c * 256 + tid; const size_t row = (size_t)b * SEQ + qpos;
    float s1 = 0.f, s2 = 0.f;
    for (int i = 0; i < 64; ++i) { s1 += lq1[i] * lk1[i]; s2 += lq2[i] * lk2[i]; }
    const float lam = expf(s1) - expf(s2) + lam_init;
    const float slope2 = exp2f(-2.0f * (float)(hd + 1)) * LOG2E;
    float q[64], o[64], o1[64];
    for (int mp = 0; mp < 2; ++mp) {
#pragma unroll
        for (int d = 0; d < 64; ++d) { q[d] = bf2f(proj[row * INW + PC_QD + hd * 128 + mp * 64 + d]); o[d] = 0.f; }
        float m = -INFINITY, l = 0.f;
        for (int j = c; j >= 0; --j)
            for (int kt = 3; kt >= 0; --kt) {
                __syncthreads();
                { const int r = tid >> 2, qd = tid & 3; const bf16* kp = proj + ((size_t)b * SEQ + j * 256 + kt * 64 + r) * INW;
#pragma unroll
                  for (int i = 0; i < 16; ++i) { Ks[r][qd * 16 + i] = bf2f(kp[PC_KD + hd * 128 + mp * 64 + qd * 16 + i]); Vs[r][qd * 16 + i] = bf2f(kp[PC_VD + hd * 128 + vh * 64 + qd * 16 + i]); } }
                __syncthreads();
                for (int k = 63; k >= 0; --k) { const int kpos = j * 256 + kt * 64 + k; if (kpos > qpos) continue;
                    float s = 0.f;
#pragma unroll
                    for (int d = 0; d < 64; ++d) s += q[d] * Ks[k][d];
                    s += slope2 * (float)(kpos - qpos);
                    if (s > m) { const float a = exp2f(m - s); l *= a;
#pragma unroll
                        for (int d = 0; d < 64; ++d) o[d] *= a;
                        m = s; }
                    const float p = exp2f(s - m); l += p;
#pragma unroll
                    for (int d = 0; d < 64; ++d) o[d] += p * Vs[k][d]; }
            }
        const float il = 1.f / l;
        if (mp == 0) {
#pragma unroll
            for (int d = 0; d < 64; ++d) o1[d] = o[d] * il;
        } else {
#pragma unroll
            for (int d = 0; d < 64; ++d) Dbuf[row * DW + hd * 128 + vh * 64 + d] = o1[d] - lam * (o[d] * il);
        }
    }
}
#endif

typedef const __attribute__((address_space(4))) Args* kargs_t;
__global__ void __launch_bounds__(NWAVES * 64, 2) mk_fwd(Args args_unused) {
    extern __shared__ __attribute__((aligned(16))) unsigned char lds[];
    LAS unsigned char* L = (LAS unsigned char*)lds;
    volatile LAS unsigned* MISC = (volatile LAS unsigned*)(L + MISC_OFF);
    for (int u = threadIdx.x; u < (LDS_BYTES - LDSCTL_OFF) / 4; u += NWAVES * 64) ((LAS unsigned*)(L + LDSCTL_OFF))[u] = 0u;
    __syncthreads();
    kargs_t ap0 = (kargs_t)__builtin_amdgcn_kernarg_segment_ptr();
    const int lo = ap0->ph_lo, hi = ap0->ph_hi;
    XcdBarrier bar; bar.bar = (unsigned*)((gu32*)(ap0->ws + WS_CTL) + CW_BAR) + ap0->li * XCD_BAR_WORDS; bar.x = 0; bar.st = MISC + 8;
    if (hi - lo > 1) bar = xcd_barrier_post(bar.bar, MISC + 8);

    for (int ph = lo; ph < hi; ++ph) {
        if (ph > lo) xcd_barrier(bar);
        kargs_t P = (kargs_t)__builtin_amdgcn_kernarg_segment_ptr(); asm volatile("" : "+s"(P));
        int tid = threadIdx.x; asm volatile("" : "+v"(tid));
        const int lane = tid & 63, wave = __builtin_amdgcn_readfirstlane(tid >> 6);
        int G = gridDim.x, bx = blockIdx.x; asm volatile("" : "+s"(G), "+s"(bx));
        const int vcu = (G % 8 == 0) ? (bx % 8) * (G / 8) + bx / 8 : bx;
        const int gw = vcu * NWAVES + wave, NGW = G * NWAVES;
        unsigned char* ws = P->ws;
        bf16* H = (bf16*)(ws + WS_H); float* Y = (float*)(ws + WS_Y); float* Dbuf = (float*)(ws + WS_Y);
        bf16* BIG = (bf16*)(ws + WS_BIG); float* kmean = (float*)(ws + WS_KMEAN); unsigned* sel = (unsigned*)(ws + WS_SEL);
        if (ph == 0) { prologue_phase(P, L, gw, NGW, wave, lane); continue; }
        const int l = (ph - 1) / PH_PER_LAYER, k = (ph - 1) % PH_PER_LAYER;
        unsigned char* wl = ws + WS_W + (size_t)l * W_LAYER;
        if (k == 0 || k == 10) {
            pg8::Gemm g{H, (const bf16*)(wl + (k == 0 ? W_GU1 : W_GU2)), M, NGU, DM}; pg8::StaticOrder S; S.init(M, NGU, G, bx);
            pg8::EpiSwiGLU E{BIG, FF};
            pg8::gemm_phase<pg8::EpiSwiGLU, pg8::StaticOrder, true, true>(L + RING_OFF, g, S, E);
        } else if (k == 1 || k == 11) {
            pg8::Gemm g{BIG, (const bf16*)(wl + (k == 1 ? W_DN1 : W_DN2)), M, DM, FF}; pg8::StaticOrder S; S.init(M, DM, G, bx);
            pg8::EpiF32 E{Y, DM};
            pg8::gemm_phase<pg8::EpiF32, pg8::StaticOrder, true, true>(L + RING_OFF, g, S, E);
        } else if (k == 8) {
            pg8::Gemm g{H, (const bf16*)(wl + W_OUT), M, DM, DM}; pg8::StaticOrder S; S.init(M, DM, G, bx);
            pg8::EpiF32 E{Y, DM};
            pg8::gemm_phase<pg8::EpiF32, pg8::StaticOrder, true, true>(L + RING_OFF, g, S, E);
        } else if (k == 3) {
            pg8::Gemm g{H, (const bf16*)(wl + W_IN), M, INW, DM}; pg8::StaticOrder S; S.init(M, INW, G, bx);
            pg8::EpiProj E{BIG, INW, 0xC3u, C2};
            pg8::gemm_phase<pg8::EpiProj, pg8::StaticOrder, true, true>(L + RING_OFF, g, S, E);
        } else if (k == 2 || k == 9 || k == 12) {
            const float* xsrc = (l == 0 && k == 2) ? P->in[0] : P->out;
            const float coef = (k == 9) ? 1.0f : 0.5f;
            const float* gpost = (k == 2 ? P->in[5] : k == 9 ? P->in[14] : P->in[19]) + (size_t)l * DM;
            const float* gnext = (k == 2) ? P->in[6] + (size_t)l * DM : (k == 9) ? P->in[15] + (size_t)l * DM : (l + 1 < DEPTH ? P->in[1] + (size_t)(l + 1) * DM : nullptr);
            ew_phase(xsrc, Y, P->out, coef, gpost, gnext, H, gw, NGW, lane);
        } else if (k == 4) {
            kmean_phase(BIG, kmean, (LAS float*)(L + RING_OFF), vcu, G, tid);
        } else if (k == 5) {
            gate_phase(BIG, kmean, sel, vcu, G, tid);
        } else if (k == 6) {
        } else if (k == 7) {
            diffnorm_phase(Dbuf, P->in[12] + (size_t)l * 128, 1.0f - lam_init_of(l), H, gw, NGW, lane);
        }
    }
}

extern "C" void kernel_launch(void* const* d_in, const int* in_sizes, int n_in, void* d_out, int out_size, void* d_ws, size_t ws_size, hipStream_t stream) {
    static int grid = 0;
    if (grid == 0) {
        if (n_in != 20 || in_sizes[0] != M * DM || out_size != M * DM || ws_size < WS_END) { fprintf(stderr, "kernel_launch: unexpected shapes (n_in %d, in0 %d, out %d, ws %zu); nothing launched\n", n_in, n_in > 0 ? in_sizes[0] : -1, out_size, ws_size); grid = -1; return; }
        int dev = 0, cus = 0;
        if (hipGetDevice(&dev) != hipSuccess || hipDeviceGetAttribute(&cus, hipDeviceAttributeMultiprocessorCount, dev) != hipSuccess) { grid = -1; return; }
        if (hipFuncSetAttribute((const void*)mk_fwd, hipFuncAttributeMaxDynamicSharedMemorySize, LDS_BYTES) != hipSuccess) { fprintf(stderr, "kernel_launch: hipFuncSetAttribute failed\n"); grid = -1; return; }
        (void)hipGetLastError();
        grid = cus;
    }
    if (grid < 0) return;
    (void)hipMemsetAsync((char*)d_ws + WS_CTL, 0, CTL_ZERO_BYTES, stream);
    Args a{};
    for (int i = 0; i < 20; ++i) a.in[i] = (const float*)d_in[i];
    a.out = (float*)d_out; a.ws = (unsigned char*)d_ws;
#if N_LAUNCH_MODE == 1
    a.ph_lo = 0; a.ph_hi = NPHASE; a.li = 0;
    hipLaunchKernelGGL(mk_fwd, dim3(grid), dim3(NWAVES * 64), LDS_BYTES, stream, a);
#else
    for (int ph = 0; ph < NPHASE; ++ph) {
        a.ph_lo = ph; a.ph_hi = ph + 1; a.li = 0;
#if REF_ATTN
        if (ph >= 1 && (ph - 1) % PH_PER_LAYER == 6) {
            const int l = (ph - 1) / PH_PER_LAYER; unsigned char* ws = (unsigned char*)d_ws;
            hipLaunchKernelGGL(ref_moba, dim3(BATCH * NHM * 16), dim3(256), 0, stream, (const bf16*)(ws + WS_BIG), (const unsigned*)(ws + WS_SEL), (bf16*)(ws + WS_H));
            hipLaunchKernelGGL(ref_diff, dim3(BATCH * NHD * 2 * 16), dim3(256), 0, stream, (const bf16*)(ws + WS_BIG), (const float*)d_in[8] + l * 64, (const float*)d_in[9] + l * 64,
                               (const float*)d_in[10] + l * 64, (const float*)d_in[11] + l * 64, l == 0 ? 0.2f : 0.35550907f, (float*)(ws + WS_Y));
            continue;
        }
#endif
        hipLaunchKernelGGL(mk_fwd, dim3(grid), dim3(NWAVES * 64), LDS_BYTES, stream, a);
    }
#endif
}
```

```cpp
#include <hip/hip_runtime.h>
#include <cstdio>
#include <cstdint>
#include <cmath>
#ifndef N_LAUNCH_MODE
#define N_LAUNCH_MODE 1
#endif
#ifndef REF_ATTN
#define REF_ATTN 0
#endif
namespace pg8 {
#define PG8_LAS __attribute__((address_space(3)))
typedef unsigned short bf16_t;
typedef short bf16x8 __attribute__((ext_vector_type(8)));
typedef float f32x4 __attribute__((ext_vector_type(4)));
typedef unsigned u32x4 __attribute__((ext_vector_type(4)));
constexpr int BM = 256, BK = 64, HALF = 128, HTB = HALF * BK * 2  , STAGE_BYTES = 8 * HTB, NXCD = 8, WGM = 8;

__host__ __device__ __forceinline__ int lds_byte(int r, int c) { const int st = (r >> 4) * 2 + (c >> 5), rr = r & 15, cc = c & 31, ob = rr * 64 + cc * 2; return st * 1024 + (ob ^ (((ob >> 9) & 1) << 5)); }
__host__ __device__ __forceinline__ void stage_rc(int b, int& R, int& C) { const int st = b / 1024, sb = b % 1024, swz = sb ^ (((sb >> 9) & 1) << 5); R = (st >> 1) * 16 + swz / 64; C = (st & 1) * 32 + (swz % 64) / 2; }
__host__ __device__ __forceinline__ int perm32(int rho) { const int n = rho >> 4, i = rho & 15; return 8 * (i >> 2) + 4 * n + (i & 3); }

struct Unit { int pm, pn; };
struct Gemm { const bf16_t* A; const bf16_t* Bt; int M, N, K; };

struct StaticOrder {
    int nM, nN, nwg, G, c;
    __host__ __device__ void init(int M, int N, int G_, int c_) { nM = M / BM; nN = N / BM; nwg = nM * nN; G = G_; c = c_; }
    __host__ __device__ bool next(int i, Unit& u) const {
        const long L = (long)i * G + c; if (L >= nwg) return false;
        int wgid = (int)L; { const int q = nwg / NXCD, r = nwg % NXCD, xcd = wgid % NXCD, off = wgid / NXCD; wgid = (xcd < r ? xcd * (q + 1) : r * (q + 1) + (xcd - r) * q) + off; }
        const int nig = WGM * nN, gid = wgid / nig, fm = gid * WGM, gsz = (nM - fm) < WGM ? (nM - fm) : WGM;
        u.pm = fm + ((wgid % nig) % gsz); u.pn = (wgid % nig) / gsz; return true;
    }
    __device__ __forceinline__ void a_ready(const Unit&) const {}
    __device__ __forceinline__ void done(const Unit&) const {}
};

__device__ __forceinline__ unsigned cvt_pk_bf16(float lo, float hi) { unsigned r; asm volatile("v_cvt_pk_bf16_f32 %0, %1, %2" : "=v"(r) : "v"(lo), "v"(hi)); return r; }
typedef float f32x2 __attribute__((ext_vector_type(2)));

struct EpiF32 {
    static constexpr bool PERM = false, AFTER_DRAIN = false;
    float* C; int ldc;
    __device__ __forceinline__ void operator()(const f32x4 (&acc)[2][2][4][2], const Unit& u, int wr, int wc, int fr, int fq) const {
        const int row0 = u.pm * BM + wr * 64 + fr, col0 = u.pn * BM + wc * 32 + 4 * fq;
#pragma unroll
        for (int ai = 0; ai < 2; ++ai)
#pragma unroll
            for (int m = 0; m < 4; ++m) { float* rowp = C + (size_t)(row0 + ai * HALF + m * 16) * ldc + col0;
#pragma unroll
                for (int bj = 0; bj < 2; ++bj)
#pragma unroll
                    for (int n = 0; n < 2; ++n) *(f32x4*)(rowp + bj * HALF + n * 16) = acc[ai][bj][m][n]; }
    }
};
struct EpiProj {
    static constexpr bool PERM = true, AFTER_DRAIN = false;
    bf16_t* O; int ldc; unsigned qmask; float qscale;
    __device__ __forceinline__ void operator()(const f32x4 (&acc)[2][2][4][2], const Unit& u, int wr, int wc, int fr, int fq) const {
        const int row0 = u.pm * BM + wr * 64 + fr; const int col0 = u.pn * BM + wc * 32 + 8 * fq;
        const float sc = ((qmask >> u.pn) & 1u) ? qscale : 1.f;
#pragma unroll
        for (int ai = 0; ai < 2; ++ai)
#pragma unroll
            for (int m = 0; m < 4; ++m) { bf16_t* rowp = O + (size_t)(row0 + ai * HALF + m * 16) * ldc + col0;
#pragma unroll
                for (int bj = 0; bj < 2; ++bj) { const f32x4 v0 = acc[ai][bj][m][0] * sc, v1 = acc[ai][bj][m][1] * sc;
                    u32x4 w; w.x = cvt_pk_bf16(v0[0], v0[1]); w.y = cvt_pk_bf16(v0[2], v0[3]); w.z = cvt_pk_bf16(v1[0], v1[1]); w.w = cvt_pk_bf16(v1[2], v1[3]);
                    *(u32x4*)(rowp + bj * HALF) = w; } }
    }
};
__device__ __forceinline__ float silu_mul(float g, float u) { const float e = __builtin_amdgcn_exp2f(g * -1.4426950408889634f); return g * __builtin_amdgcn_rcpf(1.0f + e) * u; }
struct EpiSwiGLU {
    static constexpr bool PERM = true, AFTER_DRAIN = false;
    bf16_t* O; int ldc;
    __device__ __forceinline__ void operator()(const f32x4 (&acc)[2][2][4][2], const Unit& u, int wr, int wc, int fr, int fq) const {
        const int row0 = u.pm * BM + wr * 64 + fr; const int col0 = u.pn * HALF + wc * 32 + 8 * fq;
#pragma unroll
        for (int ai = 0; ai < 2; ++ai)
#pragma unroll
            for (int m = 0; m < 4; ++m) { bf16_t* rowp = O + (size_t)(row0 + ai * HALF + m * 16) * ldc + col0;
                const f32x4 g0 = acc[ai][0][m][0], g1 = acc[ai][0][m][1], u0 = acc[ai][1][m][0], u1 = acc[ai][1][m][1];
                u32x4 w;
                w.x = cvt_pk_bf16(silu_mul(g0[0], u0[0]), silu_mul(g0[1], u0[1])); w.y = cvt_pk_bf16(silu_mul(g0[2], u0[2]), silu_mul(g0[3], u0[3]));
                w.z = cvt_pk_bf16(silu_mul(g1[0], u1[0]), silu_mul(g1[1], u1[1])); w.w = cvt_pk_bf16(silu_mul(g1[2], u1[2]), silu_mul(g1[3], u1[3]));
                *(u32x4*)rowp = w; }
    }
};

template <class Epi, class Sched, bool ALIGN_EPI = false, bool SP2 = false>
__device__ __forceinline__ void gemm_phase(PG8_LAS unsigned char* lds, const Gemm g, const Sched& S, const Epi& E) {
    int tid_l = threadIdx.x; asm volatile("" : "+v"(tid_l));
    const int tid = tid_l, wid = __builtin_amdgcn_readfirstlane(tid >> 6), lane = tid & 63, wr = wid >> 2, wc = wid & 3, fr = lane & 15, fq = lane >> 4;
    const int K = g.K, nt = K / BK;
    unsigned voffA[2], voffB[2];
#pragma unroll
    for (int i = 0; i < 2; ++i) { int R, C; stage_rc(tid * 16 + i * 8192, R, C); const int Rb = Epi::PERM ? ((R & ~31) + perm32(R & 31)) : R;
        voffA[i] = (unsigned)(R * K + C) * 2u; voffB[i] = (unsigned)(Rb * K + C) * 2u; }
    const size_t kstep = (size_t)(BK * 2);
    const size_t hstep = (size_t)HALF * K * 2;
    const size_t tstep = 2 * hstep;
    const unsigned ldsw = (unsigned)wid * 1024u;
    const int aoff = lds_byte(wr * 64 + fr, fq * 8), boff = lds_byte(wc * 32 + fr, fq * 8);
#define PG8_SA(b, h) (((b) * 2 + (h)) * HTB)
#define PG8_SB(b, h) ((4 + (b) * 2 + (h)) * HTB)
#define PG8_STAGE(bufoff, gbase, voff) do { _Pragma("unroll") for (int _i = 0; _i < 2; ++_i) \
        __builtin_amdgcn_global_load_lds((const unsigned*)((const char*)(gbase) + (voff)[_i]), (PG8_LAS unsigned*)(lds + (bufoff) + ldsw + _i * 8192), 16, 0, 0); } while (0)
#define PG8_LDA(dst, b, h) do { _Pragma("unroll") for (int m = 0; m < 4; ++m) _Pragma("unroll") for (int k = 0; k < 2; ++k) dst[m][k] = *(const PG8_LAS bf16x8*)(lds + PG8_SA(b, h) + aoff + m * 2048 + k * 1024); } while (0)
#define PG8_LDB(dst, b, h) do { _Pragma("unroll") for (int n = 0; n < 2; ++n) _Pragma("unroll") for (int k = 0; k < 2; ++k) dst[n][k] = *(const PG8_LAS bf16x8*)(lds + PG8_SB(b, h) + boff + n * 2048 + k * 1024); } while (0)
#define PG8_MMA(ai, bj, At, Bt) do { __builtin_amdgcn_s_setprio(1); _Pragma("unroll") for (int m = 0; m < 4; ++m) _Pragma("unroll") for (int n = 0; n < 2; ++n) _Pragma("unroll") for (int k = 0; k < 2; ++k) \
        acc[ai][bj][m][n] = __builtin_amdgcn_mfma_f32_16x16x32_bf16(Bt[n][k], At[m][k], acc[ai][bj][m][n], 0, 0, 0); __builtin_amdgcn_s_setprio(0); } while (0)
#define PG8_WAIT_V(n) asm volatile("s_waitcnt vmcnt(" #n ")" ::: "memory")
#define PG8_WAIT_L(n) asm volatile("s_waitcnt lgkmcnt(" #n ")" ::: "memory")
#define PG8_BAR __builtin_amdgcn_s_barrier()
#define PG8_SCHED __builtin_amdgcn_sched_barrier(0)
    Unit cur, nxt; int ui = 0;
    if (!S.next(0, cur)) return;
    f32x4 acc[2][2][4][2];
#pragma unroll
    for (int a = 0; a < 2; ++a)
#pragma unroll
        for (int b = 0; b < 2; ++b)
#pragma unroll
            for (int m = 0; m < 4; ++m)
#pragma unroll
                for (int n = 0; n < 2; ++n) acc[a][b][m][n] = (f32x4){0.f, 0.f, 0.f, 0.f};
    bf16x8 At[4][2], B0[2][2], B1[2][2];
    const char* cA = (const char*)g.A + (size_t)cur.pm * tstep; const char* cB = (const char*)g.Bt + (size_t)cur.pn * tstep;
    S.a_ready(cur);
    if constexpr (SP2) {
        PG8_STAGE(PG8_SB(0, 0), cB, voffB); PG8_STAGE(PG8_SB(0, 1), cB + hstep, voffB); PG8_STAGE(PG8_SA(0, 0), cA, voffA); PG8_STAGE(PG8_SA(0, 1), cA + hstep, voffA);
        if (wr == 1) PG8_BAR;
        PG8_WAIT_V(2); PG8_BAR;
        PG8_STAGE(PG8_SB(1, 0), cB + kstep, voffB); PG8_STAGE(PG8_SA(1, 0), cA + kstep, voffA); PG8_STAGE(PG8_SB(1, 1), cB + hstep + kstep, voffB);
        PG8_WAIT_V(6); PG8_BAR;
    } else {
        PG8_STAGE(PG8_SB(0, 0), cB, voffB); PG8_STAGE(PG8_SA(0, 0), cA, voffA); PG8_STAGE(PG8_SB(0, 1), cB + hstep, voffB); PG8_STAGE(PG8_SA(0, 1), cA + hstep, voffA);
        if (wr == 1) PG8_BAR;
        PG8_WAIT_V(4); PG8_BAR;
        PG8_STAGE(PG8_SB(1, 0), cB + kstep, voffB); PG8_STAGE(PG8_SA(1, 0), cA + kstep, voffA); PG8_STAGE(PG8_SB(1, 1), cB + hstep + kstep, voffB);
        PG8_WAIT_V(6); PG8_BAR;
    }
    for (;;) {
        const bool has_next = S.next(ui + 1, nxt);
        const char* nA = has_next ? (const char*)g.A + (size_t)nxt.pm * tstep : cA; const char* nB = has_next ? (const char*)g.Bt + (size_t)nxt.pn * tstep : cB;
        for (int t = 0; t < nt; t += 2) {
            const bool last = (t == nt - 2);
            const char* a1 = cA + (size_t)(t + 1) * kstep;
            const char* a2 = last ? nA : cA + (size_t)(t + 2) * kstep; const char* b2 = last ? nB : cB + (size_t)(t + 2) * kstep;
            const char* a3 = a2 + kstep; const char* b3 = b2 + kstep;
            if (last && has_next) S.a_ready(nxt);
            if constexpr (SP2) {
            PG8_LDB(B0, 0, 0); PG8_LDB(B1, 0, 1); PG8_SCHED; PG8_LDA(At, 0, 0); PG8_STAGE(PG8_SA(1, 1), a1 + hstep, voffA);
            PG8_WAIT_V(8); PG8_WAIT_L(0); PG8_BAR; PG8_MMA(0, 0, At, B0); PG8_MMA(0, 1, At, B1); PG8_BAR; PG8_SCHED;
            PG8_LDA(At, 0, 1); PG8_STAGE(PG8_SB(0, 0), b2, voffB); PG8_STAGE(PG8_SB(0, 1), b2 + hstep, voffB); PG8_STAGE(PG8_SA(0, 0), a2, voffA);
            PG8_WAIT_V(8); PG8_WAIT_L(0); PG8_BAR; PG8_MMA(1, 0, At, B0); PG8_MMA(1, 1, At, B1); PG8_BAR; PG8_SCHED;
            PG8_LDB(B0, 1, 0); PG8_LDB(B1, 1, 1); PG8_SCHED; PG8_LDA(At, 1, 0); PG8_STAGE(PG8_SA(0, 1), a2 + hstep, voffA);
            PG8_WAIT_V(8); PG8_WAIT_L(0); PG8_BAR; PG8_MMA(0, 0, At, B0); PG8_MMA(0, 1, At, B1); PG8_BAR; PG8_SCHED;
            PG8_LDA(At, 1, 1); PG8_STAGE(PG8_SB(1, 0), b3, voffB); PG8_STAGE(PG8_SB(1, 1), b3 + hstep, voffB); PG8_STAGE(PG8_SA(1, 0), a3, voffA);
            PG8_WAIT_V(8); PG8_WAIT_L(0); PG8_BAR; PG8_MMA(1, 0, At, B0); PG8_MMA(1, 1, At, B1); PG8_BAR; PG8_SCHED;
            } else {
            PG8_LDB(B0, 0, 0); PG8_SCHED; PG8_LDA(At, 0, 0); PG8_STAGE(PG8_SA(1, 1), a1 + hstep, voffA);
            PG8_WAIT_L(8); PG8_BAR; PG8_WAIT_L(0); PG8_MMA(0, 0, At, B0); PG8_BAR; PG8_SCHED;
            PG8_LDB(B1, 0, 1); PG8_STAGE(PG8_SB(0, 0), b2, voffB);
            PG8_BAR; PG8_WAIT_L(0); PG8_MMA(0, 1, At, B1); PG8_BAR;
            PG8_LDA(At, 0, 1); PG8_STAGE(PG8_SA(0, 0), a2, voffA);
            PG8_BAR; PG8_WAIT_L(0); PG8_MMA(1, 0, At, B0); PG8_BAR; PG8_SCHED;
            PG8_STAGE(PG8_SB(0, 1), b2 + hstep, voffB);
            PG8_WAIT_V(6); PG8_BAR; PG8_MMA(1, 1, At, B1); PG8_BAR;
            PG8_LDB(B0, 1, 0); PG8_SCHED; PG8_LDA(At, 1, 0); PG8_STAGE(PG8_SA(0, 1), a2 + hstep, voffA);
            PG8_WAIT_L(8); PG8_BAR; PG8_WAIT_L(0); PG8_MMA(0, 0, At, B0); PG8_BAR; PG8_SCHED;
            PG8_LDB(B1, 1, 1); PG8_STAGE(PG8_SB(1, 0), b3, voffB);
            PG8_BAR; PG8_WAIT_L(0); PG8_MMA(0, 1, At, B1); PG8_BAR;
            PG8_LDA(At, 1, 1); PG8_STAGE(PG8_SA(1, 0), a3, voffA);
            PG8_BAR; PG8_WAIT_L(0); PG8_MMA(1, 0, At, B0); PG8_BAR; PG8_SCHED;
            PG8_STAGE(PG8_SB(1, 1), b3 + hstep, voffB);
            PG8_WAIT_V(6); PG8_BAR; PG8_MMA(1, 1, At, B1); PG8_BAR;
            }
        }
        if constexpr (ALIGN_EPI) { if (wr == 0) PG8_BAR; }
        if constexpr (!Epi::AFTER_DRAIN) { E(acc, cur, wr, wc, fr, fq); S.done(cur); }
        if (!has_next) break;
#pragma unroll
        for (int a = 0; a < 2; ++a)
#pragma unroll
            for (int b = 0; b < 2; ++b)
#pragma unroll
                for (int m = 0; m < 4; ++m)
#pragma unroll
                    for (int n = 0; n < 2; ++n) acc[a][b][m][n] = (f32x4){0.f, 0.f, 0.f, 0.f};
        cur = nxt; cA = nA; cB = nB; ++ui;
        if constexpr (ALIGN_EPI) { if (wr == 1) PG8_BAR; }
    }
    PG8_WAIT_V(0);
    if constexpr (!ALIGN_EPI) { if (wr == 0) PG8_BAR; }
    PG8_BAR;
    if constexpr (Epi::AFTER_DRAIN) { E.fused(acc, cur, wr, wc, fr, fq, lds, wid, lane); S.done(cur); }
#undef PG8_SA
#undef PG8_SB
#undef PG8_STAGE
#undef PG8_LDA
#undef PG8_LDB
#undef PG8_MMA
#undef PG8_WAIT_V
#undef PG8_WAIT_L
#undef PG8_BAR
#undef PG8_SCHED
}
}
#define GAS __attribute__((address_space(1)))
#define LAS __attribute__((address_space(3)))
typedef unsigned short bf16;
typedef unsigned v4u __attribute__((ext_vector_type(4)));
typedef float f32x4 __attribute__((ext_vector_type(4)));
typedef short bf16x8 __attribute__((ext_vector_type(8)));
typedef GAS unsigned gu32;
typedef GAS unsigned long long gu64;
#define RLX_AGENT __ATOMIC_RELAXED, __HIP_MEMORY_SCOPE_AGENT
#define LDS_WAIT() asm volatile("s_waitcnt lgkmcnt(0)" ::: "memory")
#define VM_WAIT() asm volatile("s_waitcnt vmcnt(0)" ::: "memory")
__device__ __forceinline__ unsigned long long rt() { return __builtin_amdgcn_s_memrealtime(); }
__device__ __forceinline__ unsigned f2bf(float f) { unsigned u = __builtin_bit_cast(unsigned, f); return (u + 0x7fffu + ((u >> 16) & 1u)) >> 16; }
__device__ __forceinline__ unsigned pk2(float lo, float hi) { return f2bf(lo) | (f2bf(hi) << 16); }

#define XB_TMO      128
#define XB_XCNT(j)  (256  + 64 * (j))
#define XB_XSUB(j)  (1280 + 64 * (j))
#define XB_XGEN(j)  (2304 + 64 * (j))
#define XB_TOP      3328
#define XB_TOPGEN   3392
#define XCD_BAR_WORDS 3456
#define XB_SPIN_CAP (1u << 22)

__device__ __forceinline__ unsigned xb_ld(unsigned* p)              { return __hip_atomic_load(p, __ATOMIC_RELAXED, __HIP_MEMORY_SCOPE_AGENT); }
__device__ __forceinline__ unsigned xb_add(unsigned* p, unsigned v) { return __hip_atomic_fetch_add(p, v, __ATOMIC_RELAXED, __HIP_MEMORY_SCOPE_AGENT); }
__device__ __forceinline__ unsigned xb_xcc_id() { return (unsigned)__builtin_amdgcn_s_getreg((3 << 11) | 20) & 0xFu; }
#define XB_SPIN(cond, bar) do { unsigned _sp = 0; while (cond) { __builtin_amdgcn_s_sleep(1); \
    if ((++_sp & 255u) == 0u) { if (xb_ld(&(bar)[XB_TMO])) break; if (_sp > XB_SPIN_CAP) { atomicAdd(&(bar)[XB_TMO], 1u); break; } } } } while (0)

struct XcdBarrier {
    unsigned* bar; unsigned x;
    volatile LAS unsigned* st;
};

__device__ __forceinline__ XcdBarrier xcd_barrier_post(unsigned* bar, volatile LAS unsigned* st) {
    XcdBarrier b; b.bar = bar; b.x = xb_xcc_id(); b.st = st;
    if (threadIdx.x == 0) (void)xb_add(&bar[XB_XCNT(b.x)], 1u);
    return b;
}
__device__ __forceinline__ void xcd_barrier_complete(unsigned* bar, unsigned x, unsigned& nloc, unsigned& nx) {
    const unsigned G = gridDim.x * gridDim.y * gridDim.z;
    unsigned sum, cnt, mine, sp = 0u;
    for (;;) {
        sum = 0u; cnt = 0u; mine = 0u;
#pragma unroll
        for (unsigned j = 0; j < 16; ++j) { const unsigned c = xb_ld(&bar[XB_XCNT(j)]); sum += c; cnt += (c > 0u) ? 1u : 0u; mine = (j == x) ? c : mine; }
        if (sum == G) break;
        __builtin_amdgcn_s_sleep(1);
        if ((++sp & 255u) == 0u) { if (xb_ld(&bar[XB_TMO])) break; if (sp > XB_SPIN_CAP) { atomicAdd(&bar[XB_TMO], 1u); break; } }
    }
    nloc = mine > 0u ? mine : 1u; nx = cnt > 0u ? cnt : 1u;
}

__device__ __forceinline__ void xcd_barrier(const XcdBarrier& b) {
    asm volatile("s_waitcnt vmcnt(0)" ::: "memory");
    __syncthreads();
    if (threadIdx.x == 0) {
        unsigned* bar = b.bar;
        __builtin_amdgcn_s_waitcnt(0);
        unsigned nloc = b.st[0], nx = b.st[1];
        if (nloc == 0u) { xcd_barrier_complete(bar, b.x, nloc, nx); b.st[0] = nloc; b.st[1] = nx; }
        const unsigned old = xb_add(&bar[XB_XSUB(b.x)], 1u);
        const unsigned gen = old / nloc;
        if (old + 1u == (gen + 1u) * nloc) {
            __builtin_amdgcn_fence(__ATOMIC_RELEASE, "agent");
            asm volatile("s_waitcnt vmcnt(0)" ::: "memory");
            const unsigned og = xb_add(&bar[XB_TOP], 1u);
            const unsigned tg = og / nx;
            if (og + 1u == (tg + 1u) * nx) xb_add(&bar[XB_TOPGEN], 1u);
            else XB_SPIN(xb_ld(&bar[XB_TOPGEN]) == tg, bar);
            __builtin_amdgcn_fence(__ATOMIC_ACQUIRE, "agent");
            xb_add(&bar[XB_XGEN(b.x)], 1u);
            asm volatile("s_waitcnt vmcnt(0)" ::: "memory");
        } else {
            XB_SPIN(xb_ld(&bar[XB_XGEN(b.x)]) == gen, bar);
            __builtin_amdgcn_fence(__ATOMIC_ACQUIRE, "agent");
            asm volatile("s_waitcnt vmcnt(0)" ::: "memory");
        }
    }
    __syncthreads();
}

constexpr int BATCH = 8, SEQ = 4096, DM = 1024, DEPTH = 2, FF = 2816, NGU = 2 * FF, INW = 3072;
constexpr int M = BATCH * SEQ;
constexpr int NHM = 8, NHD = 4;
constexpr int MIXW = 1024, DW = 512;
constexpr float RMS_EPS = 1e-6f;
constexpr float LOG2E = 1.4426950408889634f;
constexpr float C2 = 0.125f * LOG2E;
constexpr int PC_QM = 0, PC_KM = 512, PC_VM = 1024, PC_QD = 1536, PC_KD = 2048, PC_VD = 2560;
constexpr int PH_PER_LAYER = 13, NPHASE = 1 + DEPTH * PH_PER_LAYER;

constexpr size_t MiB = 1u << 20;
constexpr size_t WS_CTL = 0, CTL_ZERO_BYTES = 1 * MiB;
constexpr size_t WS_KMEAN = 1 * MiB;
constexpr size_t WS_SEL = 2 * MiB;
constexpr size_t WS_W = 4 * MiB, W_LAYER = 41 * MiB;
constexpr size_t W_GU1 = 0, W_DN1 = 11 * MiB, W_IN = W_DN1 + 11 * MiB / 2, W_OUT = W_IN + 6 * MiB, W_GU2 = W_OUT + 2 * MiB, W_DN2 = W_GU2 + 11 * MiB;
static_assert(W_DN2 + 11 * MiB / 2 == W_LAYER, "weight map");
constexpr size_t WS_H = 88 * MiB;
constexpr size_t WS_Y = 152 * MiB;
constexpr size_t WS_BIG = 280 * MiB;
constexpr size_t WS_END = 472 * MiB;
static_assert(WS_W + DEPTH * W_LAYER <= WS_H && WS_H + (size_t)M * DM * 2 <= WS_Y && WS_Y + (size_t)M * DM * 4 <= WS_BIG && WS_BIG + (size_t)M * INW * 2 <= WS_END, "d_ws map");
constexpr int CW_TMO = 0, CW_CODE = 1, CW_BAR = 4096;

constexpr int RING_OFF = 0, SCRATCH_BYTES = 153600;
constexpr int LDSCTL_OFF = SCRATCH_BYTES, MISC_OFF = LDSCTL_OFF + 320;
constexpr int LDS_BYTES = 155648;
static_assert(MISC_OFF + 128 <= LDS_BYTES, "LDS map");
constexpr int NWAVES = 8;

__device__ __forceinline__ float bf2f(unsigned u) { return __uint_as_float(u << 16); }
__device__ __forceinline__ float wave_sum(float v) {
#pragma unroll
    for (int o = 1; o < 64; o <<= 1) v += __shfl_xor(v, o);
    return v;
}
__device__ __forceinline__ float dot4(f32x4 a, f32x4 b) { return (a.x * b.x + a.y * b.y) + (a.z * b.z + a.w * b.w); }

__device__ __forceinline__ void transpose_item(const float* W, int K, int N, bf16* WT, int kb, int nb, int dstrow0, LAS float* scr, int lane) {
    const int k0 = 64 * kb, n0 = 32 * nb;
#pragma unroll 8
    for (int i = 0; i < 32; ++i) { const int kk = 2 * i + (lane >> 5); scr[kk * 33 + (lane & 31)] = W[(size_t)(k0 + kk) * N + n0 + (lane & 31)]; }
    LDS_WAIT(); asm volatile("" ::: "memory");
    const int c = lane & 7;
#pragma unroll
    for (int j = 0; j < 4; ++j) { const int n = (lane >> 3) + 8 * j; const LAS float* s = scr + (8 * c) * 33 + n;
        v4u o; o.x = pk2(s[0 * 33], s[1 * 33]); o.y = pk2(s[2 * 33], s[3 * 33]); o.z = pk2(s[4 * 33], s[5 * 33]); o.w = pk2(s[6 * 33], s[7 * 33]);
        *(GAS v4u*)(WT + (size_t)(dstrow0 + n0 + n) * K + k0 + 8 * c) = o; }
    LDS_WAIT(); asm volatile("" ::: "memory");
}
__device__ __forceinline__ void rms_row_to_bf16(const float* xrow, const float* g, bf16* orow, int lane) {
    const GAS f32x4* xr = (const GAS f32x4*)xrow + lane; const GAS f32x4* gr = (const GAS f32x4*)g + lane;
    f32x4 v[4]; float s = 0.f;
#pragma unroll
    for (int j = 0; j < 4; ++j) { v[j] = xr[64 * j]; s += dot4(v[j], v[j]); }
    const float r = 1.f / sqrtf(wave_sum(s) * (1.f / DM) + RMS_EPS);
    GAS unsigned long long* o8 = (GAS unsigned long long*)orow + lane;
#pragma unroll
    for (int j = 0; j < 4; ++j) { const f32x4 gg = gr[64 * j]; const f32x4 h = v[j] * gg * r;
        o8[64 * j] = (unsigned long long)pk2(h.x, h.y) | ((unsigned long long)pk2(h.z, h.w) << 32); }
}
struct Args { const float* in[20]; float* out; unsigned char* ws; int ph_lo, ph_hi, li, pad; };
constexpr int ITEMS_FFW = 16 * 88, ITEMS_DNW = 44 * 32, ITEMS_INW = 16 * 96, ITEMS_OUTW = 16 * 32;
constexpr int ITEMS_LAYER = 4 * ITEMS_FFW + 2 * ITEMS_DNW + ITEMS_INW + ITEMS_OUTW;
typedef const __attribute__((address_space(4))) Args* kargs_t0;
__device__ __forceinline__ void prologue_phase(kargs_t0 Pq, LAS unsigned char* lds, int gw, int NGW, int wave, int lane) {
    LAS float* scr = (LAS float*)(lds + RING_OFF + wave * 16384);
    for (int it = gw; it < DEPTH * ITEMS_LAYER; it += NGW) {
        const int l = it / ITEMS_LAYER; int r = it % ITEMS_LAYER;
        unsigned char* wl = Pq->ws + WS_W + (size_t)l * W_LAYER;
        const size_t offF = (size_t)l * DM * FF, offI = (size_t)l * DM * INW, offO = (size_t)l * DM * DM;
        if (r < 2 * ITEMS_FFW) { const int up = r >= ITEMS_FFW; if (up) r -= ITEMS_FFW; const int kb = r / 88, nb = r % 88, n0 = 32 * nb;
            transpose_item((up ? Pq->in[3] : Pq->in[2]) + offF, DM, FF, (bf16*)(wl + W_GU1), kb, nb, 256 * (n0 >> 7) + (n0 & 127) + up * 128 - n0, scr, lane); continue; }
        r -= 2 * ITEMS_FFW;
        if (r < ITEMS_DNW) { transpose_item(Pq->in[4] + offF, FF, DM, (bf16*)(wl + W_DN1), r / 32, r % 32, 0, scr, lane); continue; }
        r -= ITEMS_DNW;
        if (r < ITEMS_INW) { transpose_item(Pq->in[7] + offI, DM, INW, (bf16*)(wl + W_IN), r / 96, r % 96, 0, scr, lane); continue; }
        r -= ITEMS_INW;
        if (r < ITEMS_OUTW) { transpose_item(Pq->in[13] + offO, DM, DM, (bf16*)(wl + W_OUT), r / 32, r % 32, 0, scr, lane); continue; }
        r -= ITEMS_OUTW;
        if (r < 2 * ITEMS_FFW) { const int up = r >= ITEMS_FFW; if (up) r -= ITEMS_FFW; const int kb = r / 88, nb = r % 88, n0 = 32 * nb;
            transpose_item((up ? Pq->in[17] : Pq->in[16]) + offF, DM, FF, (bf16*)(wl + W_GU2), kb, nb, 256 * (n0 >> 7) + (n0 & 127) + up * 128 - n0, scr, lane); continue; }
        r -= 2 * ITEMS_FFW;
        transpose_item(Pq->in[18] + offF, FF, DM, (bf16*)(wl + W_DN2), r / 32, r % 32, 0, scr, lane);
    }
    bf16* H = (bf16*)(Pq->ws + WS_H);
    for (int m = gw; m < M; m += NGW) rms_row_to_bf16(Pq->in[0] + (size_t)m * DM, Pq->in[1], H + (size_t)m * DM, lane);
}
__device__ __forceinline__ void ew_phase(const float* xsrc, const float* Y, float* xdst, float coef, const float* gpost, const float* gnext, bf16* H, int gw, int NGW, int lane) {
    for (int r = gw; r < M; r += NGW) {
        const GAS f32x4* xr = (const GAS f32x4*)(xsrc + (size_t)r * DM) + lane; const GAS f32x4* yr = (const GAS f32x4*)(Y + (size_t)r * DM) + lane;
        const GAS f32x4* g1 = (const GAS f32x4*)gpost + lane;
        f32x4 xv[4], yv[4]; float s = 0.f;
#pragma unroll
        for (int j = 0; j < 4; ++j) { yv[j] = yr[64 * j]; xv[j] = xr[64 * j]; s += dot4(yv[j], yv[j]); }
        const float r1 = coef / sqrtf(wave_sum(s) * (1.f / DM) + RMS_EPS);
        float s2 = 0.f; GAS f32x4* xo = (GAS f32x4*)(xdst + (size_t)r * DM) + lane;
#pragma unroll
        for (int j = 0; j < 4; ++j) { xv[j] = xv[j] + yv[j] * g1[64 * j] * r1; s2 += dot4(xv[j], xv[j]); xo[64 * j] = xv[j]; }
        if (gnext) {
            const float r2 = 1.f / sqrtf(wave_sum(s2) * (1.f / DM) + RMS_EPS);
            const GAS f32x4* g2 = (const GAS f32x4*)gnext + lane; GAS unsigned long long* o8 = (GAS unsigned long long*)(H + (size_t)r * DM) + lane;
#pragma unroll
            for (int j = 0; j < 4; ++j) { const f32x4 h = xv[j] * g2[64 * j] * r2; o8[64 * j] = (unsigned long long)pk2(h.x, h.y) | ((unsigned long long)pk2(h.z, h.w) << 32); }
        }
    }
}
__device__ __forceinline__ void kmean_phase(const bf16* proj, float* kmean, LAS float* scr, int vcu, int G, int tid) {
    for (int it = vcu; it < BATCH * 16; it += G) {
        const int b = it >> 4, blk = it & 15, cp = tid & 255, rh = tid >> 8;
        const bf16* p = proj + ((size_t)b * SEQ + blk * 256 + rh * 128) * INW + PC_KM + cp * 2;
        float s0 = 0.f, s1 = 0.f;
#pragma unroll 8
        for (int i = 0; i < 128; ++i) { const unsigned w = *(const GAS unsigned*)(p + (size_t)i * INW); s0 += bf2f(w & 0xffffu); s1 += bf2f(w >> 16); }
        if (rh == 1) { scr[cp * 2] = s0; scr[cp * 2 + 1] = s1; }
        __syncthreads();
        if (rh == 0) { s0 += scr[cp * 2]; s1 += scr[cp * 2 + 1]; const int col = cp * 2, h = col >> 6, d = col & 63;
            float* o = kmean + ((size_t)((b * NHM + h) * 16 + blk)) * 64 + d; o[0] = s0 * (1.f / 256.f); o[1] = s1 * (1.f / 256.f); }
        __syncthreads();
    }
}
__device__ __forceinline__ void gate_phase(const bf16* proj, const float* kmean, unsigned* sel, int vcu, int G, int tid) {
    for (int idx = vcu * 512 + tid; idx < M * NHM; idx += G * 512) {
        const int t = idx >> 3, h = idx & 7, b = t >> 12, c = (t & 4095) >> 8;
        unsigned mask;
        if (c <= 3) mask = (1u << c) - 1u;
        else {
            f32x4 q[16];
            const GAS v4u* qp = (const GAS v4u*)(proj + (size_t)t * INW + PC_QM + h * 64);
#pragma unroll
            for (int i = 0; i < 8; ++i) { const v4u w = qp[i]; q[2 * i] = (f32x4){bf2f(w.x & 0xffffu), bf2f(w.x >> 16), bf2f(w.y & 0xffffu), bf2f(w.y >> 16)};
                q[2 * i + 1] = (f32x4){bf2f(w.z & 0xffffu), bf2f(w.z >> 16), bf2f(w.w & 0xffffu), bf2f(w.w >> 16)}; }
            const GAS f32x4* km = (const GAS f32x4*)(kmean + (size_t)(b * NHM + h) * 16 * 64);
            float v0 = -INFINITY, v1 = -INFINITY, v2 = -INFINITY; int i0 = 0, i1 = 0, i2 = 0;
#pragma unroll 1
            for (int j = 0; j < c; ++j) { float s = 0.f;
#pragma unroll
                for (int i = 0; i < 16; ++i) s += dot4(q[i], km[j * 16 + i]);
                if (s > v0) { v2 = v1; i2 = i1; v1 = v0; i1 = i0; v0 = s; i0 = j; }
                else if (s > v1) { v2 = v1; i2 = i1; v1 = s; i1 = j; }
                else if (s > v2) { v2 = s; i2 = j; } }
            mask = (1u << i0) | (1u << i1) | (1u << i2);
        }
        sel[idx] = mask;
    }
}
__device__ __forceinline__ void diffnorm_phase(const float* Dbuf, const float* subg, float osc, bf16* mix, int gw, int NGW, int lane) {
    for (int r = gw; r < M; r += NGW) {
        const GAS f32x4* dr = (const GAS f32x4*)(Dbuf + (size_t)r * DW) + lane;
        const f32x4 a = dr[0], b = dr[64];
        float sa = dot4(a, a), sb = dot4(b, b);
#pragma unroll
        for (int o = 1; o < 32; o <<= 1) { sa += __shfl_xor(sa, o); sb += __shfl_xor(sb, o); }
        const float ra = osc / sqrtf(sa * (1.f / 128.f) + RMS_EPS), rb = osc / sqrtf(sb * (1.f / 128.f) + RMS_EPS);
        const f32x4 g = ((const GAS f32x4*)subg)[lane & 31];
        const f32x4 oa = a * g * ra, ob = b * g * rb;
        GAS unsigned long long* o8 = (GAS unsigned long long*)(mix + (size_t)r * MIXW + DW) + lane;
        o8[0] = (unsigned long long)pk2(oa.x, oa.y) | ((unsigned long long)pk2(oa.z, oa.w) << 32);
        o8[64] = (unsigned long long)pk2(ob.x, ob.y) | ((unsigned long long)pk2(ob.z, ob.w) << 32);
    }
}
__device__ __forceinline__ float lam_init_of(int l) { return l == 0 ? 0.2f : 0.35550907f; }

#if REF_ATTN
__global__ void __launch_bounds__(256) ref_moba(const bf16* proj, const unsigned* sel, bf16* mix) {
    __shared__ float Ks[64][64], Vs[64][64];
    const int bid = blockIdx.x, c = bid & 15, h = (bid >> 4) & 7, b = bid >> 7, tid = threadIdx.x;
    const int qpos = c * 256 + tid; const size_t row = (size_t)b * SEQ + qpos;
    float q[64], o[64];
#pragma unroll
    for (int d = 0; d < 64; ++d) { q[d] = bf2f(proj[row * INW + PC_QM + h * 64 + d]); o[d] = 0.f; }
    const unsigned smask = sel[row * NHM + h];
    const float slope2 = exp2f(-(float)(h + 1)) * LOG2E;
    float m = -INFINITY, l = 0.f;
    for (int j = c; j >= 0; --j) {
        const bool act = (j == c) || ((smask >> j) & 1u);
        for (int kt = 3; kt >= 0; --kt) {
            __syncthreads();
            { const int r = tid >> 2, qd = tid & 3; const bf16* kp = proj + ((size_t)b * SEQ + j * 256 + kt * 64 + r) * INW + h * 64 + qd * 16;
#pragma unroll
              for (int i = 0; i < 16; ++i) { Ks[r][qd * 16 + i] = bf2f(kp[PC_KM + i]); Vs[r][qd * 16 + i] = bf2f(kp[PC_VM + i]); } }
            __syncthreads();
            if (act) for (int k = 63; k >= 0; --k) { const int kpos = j * 256 + kt * 64 + k; if (kpos > qpos) continue;
                float s = 0.f;
#pragma unroll
                for (int d = 0; d < 64; ++d) s += q[d] * Ks[k][d];
                s += slope2 * (float)(kpos - qpos);
                if (s > m) { const float a = exp2f(m - s); l *= a;
#pragma unroll
                    for (int d = 0; d < 64; ++d) o[d] *= a;
                    m = s; }
                const float p = exp2f(s - m); l += p;
#pragma unroll
                for (int d = 0; d < 64; ++d) o[d] += p * Vs[k][d]; }
        }
    }
    const float il = 1.f / l;
#pragma unroll
    for (int d = 0; d < 64; ++d) mix[row * MIXW + h * 64 + d] = (bf16)f2bf(o[d] * il);
}
__global__ void __launch_bounds__(256) ref_diff(const bf16* proj, const float* lq1, const float* lk1, const float* lq2, const float* lk2, float lam_init, float* Dbuf) {
    __shared__ float Ks[64][64], Vs[64][64];
    const int bid = blockIdx.x, c = bid & 15, vh = (bid >> 4) & 1, hd = (bid >> 5) & 3, b = bid >> 7, tid = threadIdx.x;
    const int qpos = c * 256 + tid; const size_t row = (size_t)b * SEQ + qpos;
    float s1 = 0.f, s2 = 0.f;
    for (int i = 0; i < 64; ++i) { s1 += lq1[i] * lk1[i]; s2 += lq2[i] * lk2[i]; }
    const float lam = expf(s1) - expf(s2) + lam_init;
    const float slope2 = exp2f(-2.0f * (float)(hd + 1)) * LOG2E;
    float q[64], o[64], o1[64];
    for (int mp = 0; mp < 2; ++mp) {
#pragma unroll
        for (int d = 0; d < 64; ++d) { q[d] = bf2f(proj[row * INW + PC_QD + hd * 128 + mp * 64 + d]); o[d] = 0.f; }
        float m = -INFINITY, l = 0.f;
        for (int j = c; j >= 0; --j)
            for (int kt = 3; kt >= 0; --kt) {
                __syncthreads();
                { const int r = tid >> 2, qd = tid & 3; const bf16* kp = proj + ((size_t)b * SEQ + j * 256 + kt * 64 + r) * INW;
#pragma unroll
                  for (int i = 0; i < 16; ++i) { Ks[r][qd * 16 + i] = bf2f(kp[PC_KD + hd * 128 + mp * 64 + qd * 16 + i]); Vs[r][qd * 16 + i] = bf2f(kp[PC_VD + hd * 128 + vh * 64 + qd * 16 + i]); } }
                __syncthreads();
                for (int k = 63; k >= 0; --k) { const int kpos = j * 256 + kt * 64 + k; if (kpos > qpos) continue;
                    float s = 0.f;
#pragma unroll
                    for (int d = 0; d < 64; ++d) s += q[d] * Ks[k][d];
                    s += slope2 * (float)(kpos - qpos);
                    if (s > m) { const float a = exp2f(m - s); l *= a;
#pragma unroll
                        for (int d = 0; d < 64; ++d) o[d] *= a;
                        m = s; }
                    const float p = exp2f(s - m); l += p;
#pragma unroll
                    for (int d = 0; d < 64; ++d) o[d] += p * Vs[k][d]; }
            }
        const float il = 1.f / l;
        if (mp == 0) {
#pragma unroll
            for (int d = 0; d < 64; ++d) o1[d] = o[d] * il;
        } else {
#pragma unroll
            for (int d = 0; d < 64; ++d) Dbuf[row * DW + hd * 128 + vh * 64 + d] = o1[d] - lam * (o[d] * il);
        }
    }
}
#endif

__device__ __forceinline__ void scalar_attn_item(int kind, int stream, int pairi, const bf16* proj, const unsigned* sel, bf16* mix, float* Dbuf, float lam, LAS float* Ks, LAS float* Vs, int tid) {
    const int c = 2 * pairi + (tid >> 8), cmax = 2 * pairi + 1, qi = tid & 255;
    int b, qcol, kcol, vcol; float slope2;
    if (kind == 0) { const int h = stream & 7; b = stream >> 3; qcol = PC_QM + h * 64; kcol = PC_KM + h * 64; vcol = PC_VM + h * 64; slope2 = exp2f(-(float)(h + 1)) * LOG2E; }
    else { const int vh = stream & 1, hd = (stream >> 1) & 3; b = stream >> 3; qcol = PC_QD + hd * 128; kcol = PC_KD + hd * 128; vcol = PC_VD + hd * 128 + vh * 64; slope2 = exp2f(-2.0f * (float)(hd + 1)) * LOG2E; }
    const int qpos = c * 256 + qi; const size_t row = (size_t)b * SEQ + qpos;
    const unsigned smask = (kind == 0) ? sel[row * NHM + (stream & 7)] : 0xffffu;
    for (int mp = 0; mp <= kind; ++mp) {
        float q[64], o[64];
#pragma unroll
        for (int d = 0; d < 64; ++d) { q[d] = bf2f(proj[row * INW + qcol + mp * 64 + d]); o[d] = 0.f; }
        float m = -INFINITY, l = 0.f;
        for (int j = cmax; j >= 0; --j) {
            const bool act = (j == c) || (j < c && ((smask >> j) & 1u));
            for (int kt = 3; kt >= 0; --kt) {
                __syncthreads();
                { const int r = tid >> 3, od = tid & 7; const bf16* kp = proj + ((size_t)b * SEQ + j * 256 + kt * 64 + r) * INW;
#pragma unroll
                  for (int i = 0; i < 8; ++i) { Ks[r * 64 + od * 8 + i] = bf2f(kp[kcol + mp * 64 + od * 8 + i]); Vs[r * 64 + od * 8 + i] = bf2f(kp[vcol + od * 8 + i]); } }
                __syncthreads();
                if (act) for (int k = 63; k >= 0; --k) { const int kpos = j * 256 + kt * 64 + k; if (kpos > qpos) continue;
                    float s = 0.f;
#pragma unroll
                    for (int d = 0; d < 64; ++d) s += q[d] * Ks[k * 64 + d];
                    s += slope2 * (float)(kpos - qpos);
                    if (s > m) { const float a = exp2f(m - s); l *= a;
#pragma unroll
                        for (int d = 0; d < 64; ++d) o[d] *= a;
                        m = s; }
                    const float p = exp2f(s - m); l += p;
#pragma unroll
                    for (int d = 0; d < 64; ++d) o[d] += p * Vs[k * 64 + d]; }
            }
        }
        const float il = 1.f / l;
        if (kind == 0) {
#pragma unroll
            for (int d = 0; d < 64; ++d) mix[row * MIXW + (stream & 7) * 64 + d] = (bf16)f2bf(o[d] * il);
        } else { float* dp = Dbuf + row * DW + ((stream >> 1) & 3) * 128 + (stream & 1) * 64;
            if (mp == 0) {
#pragma unroll
                for (int d = 0; d < 64; ++d) dp[d] = o[d] * il;
            } else {
#pragma unroll
                for (int d = 0; d < 64; ++d) dp[d] = dp[d] - lam * (o[d] * il);
            } }
    }
}
__device__ __forceinline__ void scalar_attn_phase(const bf16* proj, const unsigned* sel, bf16* mix, float* Dbuf, float lam, LAS float* scr, int vcu, int G, int tid) {
    for (int it = vcu; it < 1024; it += G) {
        const int kind = it >> 9, r = it & 511, stream = r >> 3, pairi = ((r >> 3) & 1) ? (r & 7) : 7 - (r & 7);
        scalar_attn_item(kind, stream, pairi, proj, sel, mix, Dbuf, lam, scr, scr + 4096, tid);
    }
    __syncthreads();
}

typedef const __attribute__((address_space(4))) Args* kargs_t;
__global__ void __launch_bounds__(NWAVES * 64, 2) mk_fwd(Args args_unused) {
    extern __shared__ __attribute__((aligned(16))) unsigned char lds[];
    LAS unsigned char* L = (LAS unsigned char*)lds;
    volatile LAS unsigned* MISC = (volatile LAS unsigned*)(L + MISC_OFF);
    for (int u = threadIdx.x; u < (LDS_BYTES - LDSCTL_OFF) / 4; u += NWAVES * 64) ((LAS unsigned*)(L + LDSCTL_OFF))[u] = 0u;
    __syncthreads();
    kargs_t ap0 = (kargs_t)__builtin_amdgcn_kernarg_segment_ptr();
    const int lo = ap0->ph_lo, hi = ap0->ph_hi;
    XcdBarrier bar; bar.bar = (unsigned*)((gu32*)(ap0->ws + WS_CTL) + CW_BAR) + ap0->li * XCD_BAR_WORDS; bar.x = 0; bar.st = MISC + 8;
    if (hi - lo > 1) bar = xcd_barrier_post(bar.bar, MISC + 8);

    for (int ph = lo; ph < hi; ++ph) {
        if (ph > lo) xcd_barrier(bar);
        kargs_t P = (kargs_t)__builtin_amdgcn_kernarg_segment_ptr(); asm volatile("" : "+s"(P));
        int tid = threadIdx.x; asm volatile("" : "+v"(tid));
        const int lane = tid & 63, wave = __builtin_amdgcn_readfirstlane(tid >> 6);
        int G = gridDim.x, bx = blockIdx.x; asm volatile("" : "+s"(G), "+s"(bx));
        const int vcu = (G % 8 == 0) ? (bx % 8) * (G / 8) + bx / 8 : bx;
        const int gw = vcu * NWAVES + wave, NGW = G * NWAVES;
        unsigned char* ws = P->ws;
        bf16* H = (bf16*)(ws + WS_H); float* Y = (float*)(ws + WS_Y); float* Dbuf = (float*)(ws + WS_Y);
        bf16* BIG = (bf16*)(ws + WS_BIG); float* kmean = (float*)(ws + WS_KMEAN); unsigned* sel = (unsigned*)(ws + WS_SEL);
        if (ph == 0) { prologue_phase(P, L, gw, NGW, wave, lane); continue; }
        const int l = (ph - 1) / PH_PER_LAYER, k = (ph - 1) % PH_PER_LAYER;
        unsigned char* wl = ws + WS_W + (size_t)l * W_LAYER;
        if (k == 0 || k == 10) {
            pg8::Gemm g{H, (const bf16*)(wl + (k == 0 ? W_GU1 : W_GU2)), M, NGU, DM}; pg8::StaticOrder S; S.init(M, NGU, G, bx);
            pg8::EpiSwiGLU E{BIG, FF};
            pg8::gemm_phase<pg8::EpiSwiGLU, pg8::StaticOrder, true, true>(L + RING_OFF, g, S, E);
        } else if (k == 1 || k == 11) {
            pg8::Gemm g{BIG, (const bf16*)(wl + (k == 1 ? W_DN1 : W_DN2)), M, DM, FF}; pg8::StaticOrder S; S.init(M, DM, G, bx);
            pg8::EpiF32 E{Y, DM};
            pg8::gemm_phase<pg8::EpiF32, pg8::StaticOrder, true, true>(L + RING_OFF, g, S, E);
        } else if (k == 8) {
            pg8::Gemm g{H, (const bf16*)(wl + W_OUT), M, DM, DM}; pg8::StaticOrder S; S.init(M, DM, G, bx);
            pg8::EpiF32 E{Y, DM};
            pg8::gemm_phase<pg8::EpiF32, pg8::StaticOrder, true, true>(L + RING_OFF, g, S, E);
        } else if (k == 3) {
            pg8::Gemm g{H, (const bf16*)(wl + W_IN), M, INW, DM}; pg8::StaticOrder S; S.init(M, INW, G, bx);
            pg8::EpiProj E{BIG, INW, 0xC3u, C2};
            pg8::gemm_phase<pg8::EpiProj, pg8::StaticOrder, true, true>(L + RING_OFF, g, S, E);
        } else if (k == 2 || k == 9 || k == 12) {
            const float* xsrc = (l == 0 && k == 2) ? P->in[0] : P->out;
            const float coef = (k == 9) ? 1.0f : 0.5f;
            const float* gpost = (k == 2 ? P->in[5] : k == 9 ? P->in[14] : P->in[19]) + (size_t)l * DM;
            const float* gnext = (k == 2) ? P->in[6] + (size_t)l * DM : (k == 9) ? P->in[15] + (size_t)l * DM : (l + 1 < DEPTH ? P->in[1] + (size_t)(l + 1) * DM : nullptr);
            ew_phase(xsrc, Y, P->out, coef, gpost, gnext, H, gw, NGW, lane);
        } else if (k == 4) {
            kmean_phase(BIG, kmean, (LAS float*)(L + RING_OFF), vcu, G, tid);
        } else if (k == 5) {
            gate_phase(BIG, kmean, sel, vcu, G, tid);
        } else if (k == 6) {
#if !REF_ATTN
            float s1 = 0.f, s2 = 0.f;
            for (int i = 0; i < 64; ++i) { s1 += P->in[8][l * 64 + i] * P->in[9][l * 64 + i]; s2 += P->in[10][l * 64 + i] * P->in[11][l * 64 + i]; }
            const float lam = expf(s1) - expf(s2) + lam_init_of(l);
            scalar_attn_phase(BIG, sel, H, Dbuf, lam, (LAS float*)(L + RING_OFF), vcu, G, tid);
#endif
        } else if (k == 7) {
            diffnorm_phase(Dbuf, P->in[12] + (size_t)l * 128, 1.0f - lam_init_of(l), H, gw, NGW, lane);
        }
    }
}

extern "C" void kernel_launch(void* const* d_in, const int* in_sizes, int n_in, void* d_out, int out_size, void* d_ws, size_t ws_size, hipStream_t stream) {
    static int grid = 0;
    if (grid == 0) {
        if (n_in != 20 || in_sizes[0] != M * DM || out_size != M * DM || ws_size < WS_END) { fprintf(stderr, "kernel_launch: unexpected shapes (n_in %d, in0 %d, out %d, ws %zu); nothing launched\n", n_in, n_in > 0 ? in_sizes[0] : -1, out_size, ws_size); grid = -1; return; }
        int dev = 0, cus = 0;
        if (hipGetDevice(&dev) != hipSuccess || hipDeviceGetAttribute(&cus, hipDeviceAttributeMultiprocessorCount, dev) != hipSuccess) { grid = -1; return; }
        if (hipFuncSetAttribute((const void*)mk_fwd, hipFuncAttributeMaxDynamicSharedMemorySize, LDS_BYTES) != hipSuccess) { fprintf(stderr, "kernel_launch: hipFuncSetAttribute failed\n"); grid = -1; return; }
        (void)hipGetLastError();
        grid = cus;
    }
    if (grid < 0) return;
    (void)hipMemsetAsync((char*)d_ws + WS_CTL, 0, CTL_ZERO_BYTES, stream);
    Args a{};
    for (int i = 0; i < 20; ++i) a.in[i] = (const float*)d_in[i];
    a.out = (float*)d_out; a.ws = (unsigned char*)d_ws;
#if N_LAUNCH_MODE == 1
    a.ph_lo = 0; a.ph_hi = NPHASE; a.li = 0;
    hipLaunchKernelGGL(mk_fwd, dim3(grid), dim3(NWAVES * 64), LDS_BYTES, stream, a);
#else
    for (int ph = 0; ph < NPHASE; ++ph) {
        a.ph_lo = ph; a.ph_hi = ph + 1; a.li = 0;
#if REF_ATTN
        if (ph >= 1 && (ph - 1) % PH_PER_LAYER == 6) {
            const int l = (ph - 1) / PH_PER_LAYER; unsigned char* ws = (unsigned char*)d_ws;
            hipLaunchKernelGGL(ref_moba, dim3(BATCH * NHM * 16), dim3(256), 0, stream, (const bf16*)(ws + WS_BIG), (const unsigned*)(ws + WS_SEL), (bf16*)(ws + WS_H));
            hipLaunchKernelGGL(ref_diff, dim3(BATCH * NHD * 2 * 16), dim3(256), 0, stream, (const bf16*)(ws + WS_BIG), (const float*)d_in[8] + l * 64, (const float*)d_in[9] + l * 64,
                               (const float*)d_in[10] + l * 64, (const float*)d_in[11] + l * 64, l == 0 ? 0.2f : 0.35550907f, (float*)(ws + WS_Y));
            continue;
        }
#endif
        hipLaunchKernelGGL(mk_fwd, dim3(grid), dim3(NWAVES * 64), LDS_BYTES, stream, a);
    }
#endif
}
```

```cpp
#include <hip/hip_runtime.h>
#include <cstdio>
#include <cstdint>
#include <cmath>
#ifndef N_LAUNCH_MODE
#define N_LAUNCH_MODE 1
#endif
#ifndef REF_ATTN
#define REF_ATTN 0
#endif
#ifndef ATTN_IMPL
#define ATTN_IMPL 1
#endif
namespace pg8 {
#define PG8_LAS __attribute__((address_space(3)))
typedef unsigned short bf16_t;
typedef short bf16x8 __attribute__((ext_vector_type(8)));
typedef float f32x4 __attribute__((ext_vector_type(4)));
typedef unsigned u32x4 __attribute__((ext_vector_type(4)));
constexpr int BM = 256, BK = 64, HALF = 128, HTB = HALF * BK * 2  , STAGE_BYTES = 8 * HTB, NXCD = 8, WGM = 8;

__host__ __device__ __forceinline__ int lds_byte(int r, int c) { const int st = (r >> 4) * 2 + (c >> 5), rr = r & 15, cc = c & 31, ob = rr * 64 + cc * 2; return st * 1024 + (ob ^ (((ob >> 9) & 1) << 5)); }
__host__ __device__ __forceinline__ void stage_rc(int b, int& R, int& C) { const int st = b / 1024, sb = b % 1024, swz = sb ^ (((sb >> 9) & 1) << 5); R = (st >> 1) * 16 + swz / 64; C = (st & 1) * 32 + (swz % 64) / 2; }
__host__ __device__ __forceinline__ int perm32(int rho) { const int n = rho >> 4, i = rho & 15; return 8 * (i >> 2) + 4 * n + (i & 3); }

struct Unit { int pm, pn; };
struct Gemm { const bf16_t* A; const bf16_t* Bt; int M, N, K; };

struct StaticOrder {
    int nM, nN, nwg, G, c;
    __host__ __device__ void init(int M, int N, int G_, int c_) { nM = M / BM; nN = N / BM; nwg = nM * nN; G = G_; c = c_; }
    __host__ __device__ bool next(int i, Unit& u) const {
        const long L = (long)i * G + c; if (L >= nwg) return false;
        int wgid = (int)L; { const int q = nwg / NXCD, r = nwg % NXCD, xcd = wgid % NXCD, off = wgid / NXCD; wgid = (xcd < r ? xcd * (q + 1) : r * (q + 1) + (xcd - r) * q) + off; }
        const int nig = WGM * nN, gid = wgid / nig, fm = gid * WGM, gsz = (nM - fm) < WGM ? (nM - fm) : WGM;
        u.pm = fm + ((wgid % nig) % gsz); u.pn = (wgid % nig) / gsz; return true;
    }
    __device__ __forceinline__ void a_ready(const Unit&) const {}
    __device__ __forceinline__ void done(const Unit&) const {}
};

__device__ __forceinline__ unsigned cvt_pk_bf16(float lo, float hi) { unsigned r; asm volatile("v_cvt_pk_bf16_f32 %0, %1, %2" : "=v"(r) : "v"(lo), "v"(hi)); return r; }
typedef float f32x2 __attribute__((ext_vector_type(2)));

struct EpiF32 {
    static constexpr bool PERM = false, AFTER_DRAIN = false;
    float* C; int ldc;
    __device__ __forceinline__ void operator()(const f32x4 (&acc)[2][2][4][2], const Unit& u, int wr, int wc, int fr, int fq) const {
        const int row0 = u.pm * BM + wr * 64 + fr, col0 = u.pn * BM + wc * 32 + 4 * fq;
#pragma unroll
        for (int ai = 0; ai < 2; ++ai)
#pragma unroll
            for (int m = 0; m < 4; ++m) { float* rowp = C + (size_t)(row0 + ai * HALF + m * 16) * ldc + col0;
#pragma unroll
                for (int bj = 0; bj < 2; ++bj)
#pragma unroll
                    for (int n = 0; n < 2; ++n) *(f32x4*)(rowp + bj * HALF + n * 16) = acc[ai][bj][m][n]; }
    }
};
struct EpiProj {
    static constexpr bool PERM = true, AFTER_DRAIN = false;
    bf16_t* O; int ldc; unsigned qmask; float qscale;
    __device__ __forceinline__ void operator()(const f32x4 (&acc)[2][2][4][2], const Unit& u, int wr, int wc, int fr, int fq) const {
        const int row0 = u.pm * BM + wr * 64 + fr; const int col0 = u.pn * BM + wc * 32 + 8 * fq;
        const float sc = ((qmask >> u.pn) & 1u) ? qscale : 1.f;
#pragma unroll
        for (int ai = 0; ai < 2; ++ai)
#pragma unroll
            for (int m = 0; m < 4; ++m) { bf16_t* rowp = O + (size_t)(row0 + ai * HALF + m * 16) * ldc + col0;
#pragma unroll
                for (int bj = 0; bj < 2; ++bj) { const f32x4 v0 = acc[ai][bj][m][0] * sc, v1 = acc[ai][bj][m][1] * sc;
                    u32x4 w; w.x = cvt_pk_bf16(v0[0], v0[1]); w.y = cvt_pk_bf16(v0[2], v0[3]); w.z = cvt_pk_bf16(v1[0], v1[1]); w.w = cvt_pk_bf16(v1[2], v1[3]);
                    *(u32x4*)(rowp + bj * HALF) = w; } }
    }
};
__device__ __forceinline__ float silu_mul(float g, float u) { const float e = __builtin_amdgcn_exp2f(g * -1.4426950408889634f); return g * __builtin_amdgcn_rcpf(1.0f + e) * u; }
struct EpiSwiGLU {
    static constexpr bool PERM = true, AFTER_DRAIN = false;
    bf16_t* O; int ldc;
    __device__ __forceinline__ void operator()(const f32x4 (&acc)[2][2][4][2], const Unit& u, int wr, int wc, int fr, int fq) const {
        const int row0 = u.pm * BM + wr * 64 + fr; const int col0 = u.pn * HALF + wc * 32 + 8 * fq;
#pragma unroll
        for (int ai = 0; ai < 2; ++ai)
#pragma unroll
            for (int m = 0; m < 4; ++m) { bf16_t* rowp = O + (size_t)(row0 + ai * HALF + m * 16) * ldc + col0;
                const f32x4 g0 = acc[ai][0][m][0], g1 = acc[ai][0][m][1], u0 = acc[ai][1][m][0], u1 = acc[ai][1][m][1];
                u32x4 w;
                w.x = cvt_pk_bf16(silu_mul(g0[0], u0[0]), silu_mul(g0[1], u0[1])); w.y = cvt_pk_bf16(silu_mul(g0[2], u0[2]), silu_mul(g0[3], u0[3]));
                w.z = cvt_pk_bf16(silu_mul(g1[0], u1[0]), silu_mul(g1[1], u1[1])); w.w = cvt_pk_bf16(silu_mul(g1[2], u1[2]), silu_mul(g1[3], u1[3]));
                *(u32x4*)rowp = w; }
    }
};

template <class Epi, class Sched, bool ALIGN_EPI = false, bool SP2 = false>
__device__ __forceinline__ void gemm_phase(PG8_LAS unsigned char* lds, const Gemm g, const Sched& S, const Epi& E) {
    int tid_l = threadIdx.x; asm volatile("" : "+v"(tid_l));
    const int tid = tid_l, wid = __builtin_amdgcn_readfirstlane(tid >> 6), lane = tid & 63, wr = wid >> 2, wc = wid & 3, fr = lane & 15, fq = lane >> 4;
    const int K = g.K, nt = K / BK;
    unsigned voffA[2], voffB[2];
#pragma unroll
    for (int i = 0; i < 2; ++i) { int R, C; stage_rc(tid * 16 + i * 8192, R, C); const int Rb = Epi::PERM ? ((R & ~31) + perm32(R & 31)) : R;
        voffA[i] = (unsigned)(R * K + C) * 2u; voffB[i] = (unsigned)(Rb * K + C) * 2u; }
    const size_t kstep = (size_t)(BK * 2);
    const size_t hstep = (size_t)HALF * K * 2;
    const size_t tstep = 2 * hstep;
    const unsigned ldsw = (unsigned)wid * 1024u;
    const int aoff = lds_byte(wr * 64 + fr, fq * 8), boff = lds_byte(wc * 32 + fr, fq * 8);
#define PG8_SA(b, h) (((b) * 2 + (h)) * HTB)
#define PG8_SB(b, h) ((4 + (b) * 2 + (h)) * HTB)
#define PG8_STAGE(bufoff, gbase, voff) do { _Pragma("unroll") for (int _i = 0; _i < 2; ++_i) \
        __builtin_amdgcn_global_load_lds((const unsigned*)((const char*)(gbase) + (voff)[_i]), (PG8_LAS unsigned*)(lds + (bufoff) + ldsw + _i * 8192), 16, 0, 0); } while (0)
#define PG8_LDA(dst, b, h) do { _Pragma("unroll") for (int m = 0; m < 4; ++m) _Pragma("unroll") for (int k = 0; k < 2; ++k) dst[m][k] = *(const PG8_LAS bf16x8*)(lds + PG8_SA(b, h) + aoff + m * 2048 + k * 1024); } while (0)
#define PG8_LDB(dst, b, h) do { _Pragma("unroll") for (int n = 0; n < 2; ++n) _Pragma("unroll") for (int k = 0; k < 2; ++k) dst[n][k] = *(const PG8_LAS bf16x8*)(lds + PG8_SB(b, h) + boff + n * 2048 + k * 1024); } while (0)
#define PG8_MMA(ai, bj, At, Bt) do { __builtin_amdgcn_s_setprio(1); _Pragma("unroll") for (int m = 0; m < 4; ++m) _Pragma("unroll") for (int n = 0; n < 2; ++n) _Pragma("unroll") for (int k = 0; k < 2; ++k) \
        acc[ai][bj][m][n] = __builtin_amdgcn_mfma_f32_16x16x32_bf16(Bt[n][k], At[m][k], acc[ai][bj][m][n], 0, 0, 0); __builtin_amdgcn_s_setprio(0); } while (0)
#define PG8_WAIT_V(n) asm volatile("s_waitcnt vmcnt(" #n ")" ::: "memory")
#define PG8_WAIT_L(n) asm volatile("s_waitcnt lgkmcnt(" #n ")" ::: "memory")
#define PG8_BAR __builtin_amdgcn_s_barrier()
#define PG8_SCHED __builtin_amdgcn_sched_barrier(0)
    Unit cur, nxt; int ui = 0;
    if (!S.next(0, cur)) return;
    f32x4 acc[2][2][4][2];
#pragma unroll
    for (int a = 0; a < 2; ++a)
#pragma unroll
        for (int b = 0; b < 2; ++b)
#pragma unroll
            for (int m = 0; m < 4; ++m)
#pragma unroll
                for (int n = 0; n < 2; ++n) acc[a][b][m][n] = (f32x4){0.f, 0.f, 0.f, 0.f};
    bf16x8 At[4][2], B0[2][2], B1[2][2];
    const char* cA = (const char*)g.A + (size_t)cur.pm * tstep; const char* cB = (const char*)g.Bt + (size_t)cur.pn * tstep;
    S.a_ready(cur);
    if constexpr (SP2) {
        PG8_STAGE(PG8_SB(0, 0), cB, voffB); PG8_STAGE(PG8_SB(0, 1), cB + hstep, voffB); PG8_STAGE(PG8_SA(0, 0), cA, voffA); PG8_STAGE(PG8_SA(0, 1), cA + hstep, voffA);
        if (wr == 1) PG8_BAR;
        PG8_WAIT_V(2); PG8_BAR;
        PG8_STAGE(PG8_SB(1, 0), cB + kstep, voffB); PG8_STAGE(PG8_SA(1, 0), cA + kstep, voffA); PG8_STAGE(PG8_SB(1, 1), cB + hstep + kstep, voffB);
        PG8_WAIT_V(6); PG8_BAR;
    } else {
        PG8_STAGE(PG8_SB(0, 0), cB, voffB); PG8_STAGE(PG8_SA(0, 0), cA, voffA); PG8_STAGE(PG8_SB(0, 1), cB + hstep, voffB); PG8_STAGE(PG8_SA(0, 1), cA + hstep, voffA);
        if (wr == 1) PG8_BAR;
        PG8_WAIT_V(4); PG8_BAR;
        PG8_STAGE(PG8_SB(1, 0), cB + kstep, voffB); PG8_STAGE(PG8_SA(1, 0), cA + kstep, voffA); PG8_STAGE(PG8_SB(1, 1), cB + hstep + kstep, voffB);
        PG8_WAIT_V(6); PG8_BAR;
    }
    for (;;) {
        const bool has_next = S.next(ui + 1, nxt);
        const char* nA = has_next ? (const char*)g.A + (size_t)nxt.pm * tstep : cA; const char* nB = has_next ? (const char*)g.Bt + (size_t)nxt.pn * tstep : cB;
        for (int t = 0; t < nt; t += 2) {
            const bool last = (t == nt - 2);
            const char* a1 = cA + (size_t)(t + 1) * kstep;
            const char* a2 = last ? nA : cA + (size_t)(t + 2) * kstep; const char* b2 = last ? nB : cB + (size_t)(t + 2) * kstep;
            const char* a3 = a2 + kstep; const char* b3 = b2 + kstep;
            if (last && has_next) S.a_ready(nxt);
            if constexpr (SP2) {
            PG8_LDB(B0, 0, 0); PG8_LDB(B1, 0, 1); PG8_SCHED; PG8_LDA(At, 0, 0); PG8_STAGE(PG8_SA(1, 1), a1 + hstep, voffA);
            PG8_WAIT_V(8); PG8_WAIT_L(0); PG8_BAR; PG8_MMA(0, 0, At, B0); PG8_MMA(0, 1, At, B1); PG8_BAR; PG8_SCHED;
            PG8_LDA(At, 0, 1); PG8_STAGE(PG8_SB(0, 0), b2, voffB); PG8_STAGE(PG8_SB(0, 1), b2 + hstep, voffB); PG8_STAGE(PG8_SA(0, 0), a2, voffA);
            PG8_WAIT_V(8); PG8_WAIT_L(0); PG8_BAR; PG8_MMA(1, 0, At, B0); PG8_MMA(1, 1, At, B1); PG8_BAR; PG8_SCHED;
            PG8_LDB(B0, 1, 0); PG8_LDB(B1, 1, 1); PG8_SCHED; PG8_LDA(At, 1, 0); PG8_STAGE(PG8_SA(0, 1), a2 + hstep, voffA);
            PG8_WAIT_V(8); PG8_WAIT_L(0); PG8_BAR; PG8_MMA(0, 0, At, B0); PG8_MMA(0, 1, At, B1); PG8_BAR; PG8_SCHED;
            PG8_LDA(At, 1, 1); PG8_STAGE(PG8_SB(1, 0), b3, voffB); PG8_STAGE(PG8_SB(1, 1), b3 + hstep, voffB); PG8_STAGE(PG8_SA(1, 0), a3, voffA);
            PG8_WAIT_V(8); PG8_WAIT_L(0); PG8_BAR; PG8_MMA(1, 0, At, B0); PG8_MMA(1, 1, At, B1); PG8_BAR; PG8_SCHED;
            } else {
            PG8_LDB(B0, 0, 0); PG8_SCHED; PG8_LDA(At, 0, 0); PG8_STAGE(PG8_SA(1, 1), a1 + hstep, voffA);
            PG8_WAIT_L(8); PG8_BAR; PG8_WAIT_L(0); PG8_MMA(0, 0, At, B0); PG8_BAR; PG8_SCHED;
            PG8_LDB(B1, 0, 1); PG8_STAGE(PG8_SB(0, 0), b2, voffB);
            PG8_BAR; PG8_WAIT_L(0); PG8_MMA(0, 1, At, B1); PG8_BAR;
            PG8_LDA(At, 0, 1); PG8_STAGE(PG8_SA(0, 0), a2, voffA);
            PG8_BAR; PG8_WAIT_L(0); PG8_MMA(1, 0, At, B0); PG8_BAR; PG8_SCHED;
            PG8_STAGE(PG8_SB(0, 1), b2 + hstep, voffB);
            PG8_WAIT_V(6); PG8_BAR; PG8_MMA(1, 1, At, B1); PG8_BAR;
            PG8_LDB(B0, 1, 0); PG8_SCHED; PG8_LDA(At, 1, 0); PG8_STAGE(PG8_SA(0, 1), a2 + hstep, voffA);
            PG8_WAIT_L(8); PG8_BAR; PG8_WAIT_L(0); PG8_MMA(0, 0, At, B0); PG8_BAR; PG8_SCHED;
            PG8_LDB(B1, 1, 1); PG8_STAGE(PG8_SB(1, 0), b3, voffB);
            PG8_BAR; PG8_WAIT_L(0); PG8_MMA(0, 1, At, B1); PG8_BAR;
            PG8_LDA(At, 1, 1); PG8_STAGE(PG8_SA(1, 0), a3, voffA);
            PG8_BAR; PG8_WAIT_L(0); PG8_MMA(1, 0, At, B0); PG8_BAR; PG8_SCHED;
            PG8_STAGE(PG8_SB(1, 1), b3 + hstep, voffB);
            PG8_WAIT_V(6); PG8_BAR; PG8_MMA(1, 1, At, B1); PG8_BAR;
            }
        }
        if constexpr (ALIGN_EPI) { if (wr == 0) PG8_BAR; }
        if constexpr (!Epi::AFTER_DRAIN) { E(acc, cur, wr, wc, fr, fq); S.done(cur); }
        if (!has_next) break;
#pragma unroll
        for (int a = 0; a < 2; ++a)
#pragma unroll
            for (int b = 0; b < 2; ++b)
#pragma unroll
                for (int m = 0; m < 4; ++m)
#pragma unroll
                    for (int n = 0; n < 2; ++n) acc[a][b][m][n] = (f32x4){0.f, 0.f, 0.f, 0.f};
        cur = nxt; cA = nA; cB = nB; ++ui;
        if constexpr (ALIGN_EPI) { if (wr == 1) PG8_BAR; }
    }
    PG8_WAIT_V(0);
    if constexpr (!ALIGN_EPI) { if (wr == 0) PG8_BAR; }
    PG8_BAR;
    if constexpr (Epi::AFTER_DRAIN) { E.fused(acc, cur, wr, wc, fr, fq, lds, wid, lane); S.done(cur); }
#undef PG8_SA
#undef PG8_SB
#undef PG8_STAGE
#undef PG8_LDA
#undef PG8_LDB
#undef PG8_MMA
#undef PG8_WAIT_V
#undef PG8_WAIT_L
#undef PG8_BAR
#undef PG8_SCHED
}
}
namespace attn_body {
typedef unsigned short bf16;
using bf16x8=__attribute__((ext_vector_type(8)))short;
using s16x4=__attribute__((ext_vector_type(4)))short;
using f32x16=__attribute__((ext_vector_type(16)))float;
using u32x4=__attribute__((ext_vector_type(4)))unsigned;
using f32x4_t=__attribute__((ext_vector_type(4)))float;
constexpr int SEQ=4096,D=64,DM=3072;
constexpr int NW=8,QBLK=32,QB=QBLK*NW,KVBLK=64,NQB=SEQ/QB;
__device__ __forceinline__ int crow(int r,int hi){return (r&3)+8*(r>>2)+4*hi;}
#define SBAR() __builtin_amdgcn_sched_barrier(0)
__device__ __forceinline__ void cmask(f32x16&p0,f32x16&p1,int jb,int qrel,int hi){
  const float NEG=-INFINITY; int kb=64*jb+4*hi;
  #pragma unroll
  for(int r=0;r<16;++r){int kv=kb+(r&3)+8*(r>>2); if(kv>qrel)p0[r]=NEG; if(kv+32>qrel)p1[r]=NEG;}
}

constexpr int NSLOT=3, SLOTB=8192;
constexpr int LDS_K=0, LDS_V=NSLOT*SLOTB, LDS_WS=2*NSLOT*SLOTB, LDS_OST=LDS_WS+NW*64*4, LDS_STASH=LDS_OST+NW*4096, LDS_BYTES=LDS_STASH+NW*8192;
constexpr float C2_unused=0.125f*1.4426950408889634f;
__device__ __forceinline__ void glds16(const void*gsrc,unsigned lds_dst){unsigned keep;
  asm volatile("s_mov_b32 %0, m0\n\ts_mov_b32 m0, %2\n\ts_nop 0\n\tglobal_load_lds_dwordx4 %1, off\n\ts_mov_b32 m0, %0":"=&s"(keep):"v"(gsrc),"s"(lds_dst):"memory");}
__device__ __forceinline__ float max3f(float a,float b,float c){float r;asm("v_max3_f32 %0, %1, %2, %3":"=v"(r):"v"(a),"v"(b),"v"(c));return r;}
__device__ __forceinline__ float max2f(float a,float b){float r;asm("v_max_f32_e32 %0, %1, %2":"=v"(r):"v"(a),"v"(b));return r;}
__device__ __forceinline__ float fadd_s(float a,float b){float r;asm("v_add_f32_e32 %0, %1, %2":"=v"(r):"v"(a),"v"(b));return r;}
__device__ __forceinline__ float fsub_s(float a,float b){float r;asm("v_sub_f32_e32 %0, %1, %2":"=v"(r):"v"(a),"v"(b));return r;}
typedef float f32x2_t __attribute__((ext_vector_type(2))); typedef __bf16 bf16x2_t __attribute__((ext_vector_type(2)));
__device__ __forceinline__ unsigned cvtpk_s(float lo,float hi){f32x2_t v={lo,hi};bf16x2_t b=__builtin_convertvector(v,bf16x2_t);return __builtin_bit_cast(unsigned,b);}
#define WAIT_BAR(N) asm volatile("s_waitcnt vmcnt(" #N ") lgkmcnt(0)\n\ts_barrier":::"memory")

__device__ __forceinline__ void qkt(f32x16&p0,f32x16&p1,const char*Kslot,const bf16x8*qr,const f32x16&negm,int r32,int hi){
  const char*kb=Kslot+hi*1024+r32*16;
  #pragma unroll
  for(int d0=0;d0<4;++d0){
    const bf16x8 b0=*reinterpret_cast<const bf16x8*>(kb+d0*2048);
    const bf16x8 b1=*reinterpret_cast<const bf16x8*>(kb+d0*2048+512);
    if(d0==0){p0=__builtin_amdgcn_mfma_f32_32x32x16_bf16(b0,qr[0],negm,0,0,0);p1=__builtin_amdgcn_mfma_f32_32x32x16_bf16(b1,qr[0],negm,0,0,0);}
    else{p0=__builtin_amdgcn_mfma_f32_32x32x16_bf16(b0,qr[d0],p0,0,0,0);p1=__builtin_amdgcn_mfma_f32_32x32x16_bf16(b1,qr[d0],p1,0,0,0);}}
}
typedef __attribute__((address_space(3))) const char* lds_cptr;
typedef short v4i16_t __attribute__((ext_vector_type(4)));
__device__ __forceinline__ void kload8(bf16x8*kf,lds_cptr kp){
  kf[0]=*(const __attribute__((address_space(3))) bf16x8*)(kp);      kf[1]=*(const __attribute__((address_space(3))) bf16x8*)(kp+512);
  kf[2]=*(const __attribute__((address_space(3))) bf16x8*)(kp+2048); kf[3]=*(const __attribute__((address_space(3))) bf16x8*)(kp+2560);
  kf[4]=*(const __attribute__((address_space(3))) bf16x8*)(kp+4096); kf[5]=*(const __attribute__((address_space(3))) bf16x8*)(kp+4608);
  kf[6]=*(const __attribute__((address_space(3))) bf16x8*)(kp+6144); kf[7]=*(const __attribute__((address_space(3))) bf16x8*)(kp+6656);
}
__device__ __forceinline__ void kload2(bf16x8*kf,lds_cptr kp,int j){ kf[2*j]=*(const __attribute__((address_space(3))) bf16x8*)(kp+j*2048); kf[2*j+1]=*(const __attribute__((address_space(3))) bf16x8*)(kp+j*2048+512); }
__device__ __forceinline__ s16x4 vtr(lds_cptr p){ return __builtin_bit_cast(s16x4,__builtin_amdgcn_ds_read_tr16_b64_v4i16((__attribute__((address_space(3))) v4i16_t*)p)); }
__device__ __forceinline__ float rowmax(const f32x16&p0,const f32x16&p1){
  float a=max3f(p0[0],p0[1],p1[0]),b=max3f(p0[2],p0[3],p1[1]);a=max3f(a,p1[2],p1[3]);
  #pragma unroll
  for(int r=4;r<16;r+=4){a=max3f(a,p0[r],p0[r+1]);b=max3f(b,p0[r+2],p0[r+3]);a=max3f(a,p1[r],p1[r+1]);b=max3f(b,p1[r+2],p1[r+3]);}
  const float m=max2f(a,b);
  auto rr=__builtin_amdgcn_permlane32_swap(__float_as_uint(m),__float_as_uint(m),false,false);
  return max2f(__uint_as_float(rr[0]),__uint_as_float(rr[1]));
}
__device__ __forceinline__ void pv(f32x16*o,int vb,bf16x8 pa0,bf16x8 pa1,bf16x8 pa2,bf16x8 pa3){
  #pragma unroll
  for(int d0=0;d0<2;++d0){s16x4 lo[4],hi[4];
    #pragma unroll
    for(int ks=0;ks<4;++ks){
      asm volatile("ds_read_b64_tr_b16 %0,%1 offset:%c2":"=&v"(lo[ks]):"v"(vb),"i"(d0*4096+ks*1024):"memory");
      asm volatile("ds_read_b64_tr_b16 %0,%1 offset:%c2":"=&v"(hi[ks]):"v"(vb),"i"(d0*4096+ks*1024+512):"memory");}
    asm volatile("s_waitcnt lgkmcnt(0)":::"memory");SBAR();
    #define PK(k) (bf16x8){lo[k][0],lo[k][1],lo[k][2],lo[k][3],hi[k][0],hi[k][1],hi[k][2],hi[k][3]}
    o[d0]=__builtin_amdgcn_mfma_f32_32x32x16_bf16(pa0,PK(0),o[d0],0,0,0);
    o[d0]=__builtin_amdgcn_mfma_f32_32x32x16_bf16(pa1,PK(1),o[d0],0,0,0);
    o[d0]=__builtin_amdgcn_mfma_f32_32x32x16_bf16(pa2,PK(2),o[d0],0,0,0);
    o[d0]=__builtin_amdgcn_mfma_f32_32x32x16_bf16(pa3,PK(3),o[d0],0,0,0);
    #undef PK
  }
}

#ifndef ATTN_STORE16
#define ATTN_STORE16(p,v) (*(u32x4*)(p)=(v))
#endif
__device__ __forceinline__ float sbias(int k,int sexp){ if(k==0)return 0.f; const unsigned bits=__builtin_bit_cast(unsigned,(float)k*1.4426950408889634f); return __builtin_bit_cast(float,(unsigned)__builtin_amdgcn_readfirstlane((int)(bits-((unsigned)sexp<<23)))); }
template<int THRL> __device__ __forceinline__ void attn_core(int c,const bf16*Qw,const bf16*__restrict__ Kh,const bf16*__restrict__ Vh,unsigned selmask,int sexp,char*shm,f32x16(&o)[2],float&l_out){
  const float slope2=sbias(1,sexp);
  int tid_l=threadIdx.x; asm volatile("":"+v"(tid_l)); const int tid=tid_l,lane=tid&63,r32=lane&31,hi=lane>>5; const int wid=__builtin_amdgcn_readfirstlane(tid>>6);
  const unsigned lds0=(unsigned)(uintptr_t)shm;
  float*wsf=(float*)(shm+LDS_WS)+wid*64;
  const bf16*ksrc=Kh+(long)lane*DM+wid*8;
  const bf16*vsrc=Vh+(long)(16*(wid&3)+(lane>>2))*DM+(wid>>2)*32+(lane&3)*8;
  const unsigned kdst=lds0+LDS_K+wid*1024, vdst=lds0+LDS_V+wid*1024;
  #define KT(t) (((t)<4)?(4*c+(t)):(4*c+3-(t)))
  #define DMA_K(t,slot) glds16(ksrc+(long)KT(t)*KVBLK*DM,(unsigned)__builtin_amdgcn_readfirstlane(kdst+(slot)))
  #define DMA_V(t,slot) glds16(vsrc+(long)KT(t)*KVBLK*DM,(unsigned)__builtin_amdgcn_readfirstlane(vdst+(slot)))
  const int vb0=(int)(lds0+LDS_V)+((lane>>4)&1)*32+(lane&3)*8+(4*hi+((lane&15)>>2))*64;
  const char*Kbase=shm+LDS_K; bf16x8 kf[8];
  const lds_cptr shm3=(lds_cptr)shm; const lds_cptr kp0=shm3+LDS_K+hi*1024+r32*16; const lds_cptr vp0=shm3+LDS_V+((lane>>4)&1)*32+(lane&3)*8+(4*hi+((lane&15)>>2))*64;
  const int NT=4*c+4;
  #define NBV(t) (((t)<4||((selmask>>(KT(t)>>2))&1u))?__builtin_fmaf(slope2,(float)(64*KT(t)+4*hi-256*c-256),-mhat):-INFINITY)
  float sb0[16],sb1[16];
  #pragma unroll
  for(int r=0;r<16;++r){ const int k0=(r&3)+8*(r>>2); sb0[r]=sbias(k0,sexp); sb1[r]=sbias(k0+32,sexp); }
  #define BIAS(P0,P1) do{ _Pragma("unroll") for(int r=0;r<16;++r){P0[r]+=sb0[r];P1[r]+=sb1[r];} }while(0)
  DMA_K(0,0);DMA_V(0,0);DMA_K(1,SLOTB);
  bf16x8 qr[4];
  #pragma unroll
  for(int d0=0;d0<4;++d0)qr[d0]=*reinterpret_cast<const bf16x8*>(&Qw[(long)r32*DM+d0*16+hi*8]);
  float mhat=0.f,l_reg=0.f;o[0]=f32x16{};o[1]=f32x16{};f32x16 negm; { const float nb_=NBV(0); _Pragma("unroll") for(int r=0;r<16;++r)negm[r]=nb_; } asm volatile("":"+v"(negm));
  const int qrel=wid*QBLK+r32;
  #define CMASK(P0,P1,t) do{ if((t)<4)cmask(P0,P1,(t),qrel,hi); }while(0)
  bool resc=false;
  #define START(P0,P1) do{ const float rm=rowmax(P0,P1); resc=false; \
    { const float dl=rm; mhat=fadd_s(mhat,dl); \
      _Pragma("unroll") for(int r=0;r<16;++r){P0[r]=fsub_s(P0[r],dl);P1[r]=fsub_s(P1[r],dl);} } \
    _Pragma("unroll") for(int r=0;r<16;++r)P0[r]=__builtin_amdgcn_exp2f(P0[r]); }while(0)
  #define RESC() do{ if(resc){ asm volatile("s_waitcnt lgkmcnt(0)":::"memory"); \
      _Pragma("unroll") for(int d_=0;d_<2;++d_) _Pragma("unroll") for(int r=0;r<16;++r)o[d_][r]*=wsf[crow(r,hi)]; } }while(0)
  f32x16 pA0,pA1,pB0,pB1;
  int sl_prev=0,sl_cur=0,sl_next=SLOTB;
  #define ROT() do{sl_prev=sl_cur;sl_cur=sl_next;sl_next=(sl_next==(NSLOT-1)*SLOTB)?0:sl_next+SLOTB;}while(0)
  DMA_K(2,2*SLOTB);
  WAIT_BAR(3);
  qkt(pA0,pA1,Kbase,qr,negm,r32,hi);asm volatile("s_nop 15\n\ts_nop 7":"+v"(pA0),"+v"(pA1));BIAS(pA0,pA1);CMASK(pA0,pA1,0);
  START(pA0,pA1);
  _Pragma("unroll") for(int r=0;r<16;++r)pA1[r]=__builtin_amdgcn_exp2f(pA1[r]);
  WAIT_BAR(0);
  DMA_K(3,0);DMA_V(1,SLOTB);
  ROT();
  kload8(kf,kp0+sl_cur);
  WAIT_BAR(2);
  s16x4 vlo[8],vhi[8]; u32x4 pw0,pw1,pw2,pw3;
  #define PKW(P,B) cvtpk_s(P[B],P[B+1])
  #define PAF(k) __builtin_bit_cast(bf16x8,pw##k)
  #define VFR(i) (bf16x8){vlo[i][0],vlo[i][1],vlo[i][2],vlo[i][3],vhi[i][0],vhi[i][1],vhi[i][2],vhi[i][3]}
  #define PIN(x) asm volatile("":"+v"(x))
  #define MX3(a,b,c) __builtin_fmaxf(__builtin_fmaxf((a),(b)),(c))
  #define GAPA(MF,A0,A1,A2,A3,W0,W1,PW) do{ MF; sacc+=A0; sacc+=A1; sacc+=A2; sacc+=A3; PIN(sacc); W0; W1; PIN(PW); SBAR(); }while(0)
  #define EX(v) __builtin_amdgcn_exp2f(v)
  #define GAPB(MF,X,B) do{ MF; X[B]=EX(X[B]); X[B+1]=EX(X[B+1]); X[B+2]=EX(X[B+2]); X[B+3]=EX(X[B+3]); PIN(X); SBAR(); }while(0)
  #define VRD(i) do{ vlo[i]=vtr(vp_+(((i)>>2)*4096+((i)&3)*1024)); vhi[i]=vtr(vp_+(((i)>>2)*4096+((i)&3)*1024+512)); }while(0)
  #define KRD(G,j) do{ if(G){ kload2(kf,kp0+sl_next,j); SBAR(); } }while(0)
  #define STEP(C0,C1,P0,P1,t,GK,GV,GL) do{ SBAR(); \
    { const float nb_=NBV(t); _Pragma("unroll") for(int r=0;r<16;++r)negm[r]=nb_; asm volatile("":"+v"(negm)); } SBAR(); \
    const lds_cptr vp_=vp0+sl_prev; \
    VRD(0); SBAR(); float sacc=(P0[0]+P0[1]); \
    GAPA(C0=__builtin_amdgcn_mfma_f32_32x32x16_bf16(kf[0],qr[0],negm,0,0,0), P0[2],P0[3],P0[4],P0[5],     pw0[0]=PKW(P0,0), pw0[1]=PKW(P0,2), pw0); \
    VRD(4); SBAR(); GAPA(C1=__builtin_amdgcn_mfma_f32_32x32x16_bf16(kf[1],qr[0],negm,0,0,0), P0[6],P0[7],P0[8],P0[9],     pw0[2]=PKW(P0,4), pw0[3]=PKW(P0,6), pw0); \
    VRD(1); SBAR(); GAPA(C0=__builtin_amdgcn_mfma_f32_32x32x16_bf16(kf[2],qr[1],C0,0,0,0),   P0[10],P0[11],P0[12],P0[13], pw1[0]=PKW(P0,8), pw1[1]=PKW(P0,10), pw1); \
    VRD(5); SBAR(); GAPA(C1=__builtin_amdgcn_mfma_f32_32x32x16_bf16(kf[3],qr[1],C1,0,0,0),   P0[14],P0[15],P1[0],P1[1],   pw1[2]=PKW(P0,12),pw1[3]=PKW(P0,14), pw1); \
    VRD(2); SBAR(); GAPA(C0=__builtin_amdgcn_mfma_f32_32x32x16_bf16(kf[4],qr[2],C0,0,0,0),   P1[2],P1[3],P1[4],P1[5],     pw2[0]=PKW(P1,0), pw2[1]=PKW(P1,2), pw2); \
    VRD(6); SBAR(); GAPA(C1=__builtin_amdgcn_mfma_f32_32x32x16_bf16(kf[5],qr[2],C1,0,0,0),   P1[6],P1[7],P1[8],P1[9],     pw2[2]=PKW(P1,4), pw2[3]=PKW(P1,6), pw2); \
    VRD(3); SBAR(); GAPA(C0=__builtin_amdgcn_mfma_f32_32x32x16_bf16(kf[6],qr[3],C0,0,0,0),   P1[10],P1[11],P1[12],P1[13], pw3[0]=PKW(P1,8), pw3[1]=PKW(P1,10), pw3); \
    VRD(7); SBAR(); GAPA(C1=__builtin_amdgcn_mfma_f32_32x32x16_bf16(kf[7],qr[3],C1,0,0,0),   P1[14],P1[15],0.f,0.f,       pw3[2]=PKW(P1,12),pw3[3]=PKW(P1,14), pw3); \
    l_reg+=sacc; \
    if(GK){DMA_K((t)+3,sl_cur);} if(GV){DMA_V((t)+1,sl_next);} \
    BIAS(C0,C1); CMASK(C0,C1,t); \
    { float a=MX3(C0[0],C0[1],C1[0]),b=MX3(C0[2],C0[3],C1[1]); a=MX3(a,C1[2],C1[3]); \
      _Pragma("unroll") for(int r=4;r<16;r+=4){a=MX3(a,C0[r],C0[r+1]);b=MX3(b,C0[r+2],C0[r+3]);a=MX3(a,C1[r],C1[r+1]);b=MX3(b,C1[r+2],C1[r+3]);} \
      float rm=__builtin_fmaxf(a,b); { auto rr=__builtin_amdgcn_permlane32_swap(__float_as_uint(rm),__float_as_uint(rm),false,false); rm=__builtin_fmaxf(__uint_as_float(rr[0]),__uint_as_float(rr[1])); } \
      resc=false; \
      if(__builtin_expect(__any(rm>(float)THRL),0)){ const float dl=__builtin_fmaxf(rm,0.f); mhat+=dl; \
        _Pragma("unroll") for(int r=0;r<16;++r){C0[r]-=dl;C1[r]-=dl;} \
        const float f=__builtin_amdgcn_exp2f(-dl); l_reg*=f; if(hi==0)wsf[r32]=f; resc=true; } } \
    SBAR(); \
    GAPB(o[0]=__builtin_amdgcn_mfma_f32_32x32x16_bf16(PAF(0),VFR(0),o[0],0,0,0), C0,0); \
    GAPB(o[1]=__builtin_amdgcn_mfma_f32_32x32x16_bf16(PAF(0),VFR(4),o[1],0,0,0), C0,4); \
    KRD(GL,0); GAPB(o[0]=__builtin_amdgcn_mfma_f32_32x32x16_bf16(PAF(1),VFR(1),o[0],0,0,0), C0,8); \
    KRD(GL,1); GAPB(o[1]=__builtin_amdgcn_mfma_f32_32x32x16_bf16(PAF(1),VFR(5),o[1],0,0,0), C0,12); \
    KRD(GL,2); GAPB(o[0]=__builtin_amdgcn_mfma_f32_32x32x16_bf16(PAF(2),VFR(2),o[0],0,0,0), C1,0); \
    KRD(GL,3); GAPB(o[1]=__builtin_amdgcn_mfma_f32_32x32x16_bf16(PAF(2),VFR(6),o[1],0,0,0), C1,4); \
    GAPB(o[0]=__builtin_amdgcn_mfma_f32_32x32x16_bf16(PAF(3),VFR(3),o[0],0,0,0), C1,8); \
    GAPB(o[1]=__builtin_amdgcn_mfma_f32_32x32x16_bf16(PAF(3),VFR(7),o[1],0,0,0), C1,12); \
    }while(0)
  int t=1;
  #define ENDW(tt) do{ if((tt)+3<NT){WAIT_BAR(2);} else if((tt)+2<NT){WAIT_BAR(1);} else {WAIT_BAR(0);} }while(0)
  for(;t+1<NT&&t<5;t+=2){
    STEP(pB0,pB1,pA0,pA1,t,(t+3<NT),(t+1<NT),(t+1<NT));       ENDW(t);   RESC(); ROT();
    STEP(pA0,pA1,pB0,pB1,t+1,(t+4<NT),(t+2<NT),(t+2<NT));     ENDW(t+1); RESC(); ROT();
  }
  #undef CMASK
  #define CMASK(P0,P1,t) do{}while(0)
  for(;t+5<NT;t+=2){
    STEP(pB0,pB1,pA0,pA1,t,true,true,true);     WAIT_BAR(2); RESC(); ROT();
    STEP(pA0,pA1,pB0,pB1,t+1,true,true,true);   WAIT_BAR(2); RESC(); ROT();
  }
  #undef CMASK
  #define CMASK(P0,P1,t) do{ if((t)<4)cmask(P0,P1,(t),qrel,hi); }while(0)
  for(;t+1<NT;t+=2){
    STEP(pB0,pB1,pA0,pA1,t,(t+3<NT),(t+1<NT),(t+1<NT));       ENDW(t);   RESC(); ROT();
    STEP(pA0,pA1,pB0,pB1,t+1,(t+4<NT),(t+2<NT),(t+2<NT));     ENDW(t+1); RESC(); ROT();
  }
  STEP(pB0,pB1,pA0,pA1,NT-1,false,false,false); RESC();
  { float sacc=pB0[0]+pB0[1]; _Pragma("unroll") for(int r=2;r<16;++r)sacc+=pB0[r]; _Pragma("unroll") for(int r=0;r<16;++r)sacc+=pB1[r]; l_reg+=sacc;
    pw0=(u32x4){PKW(pB0,0),PKW(pB0,2),PKW(pB0,4),PKW(pB0,6)};pw1=(u32x4){PKW(pB0,8),PKW(pB0,10),PKW(pB0,12),PKW(pB0,14)};pw2=(u32x4){PKW(pB1,0),PKW(pB1,2),PKW(pB1,4),PKW(pB1,6)};pw3=(u32x4){PKW(pB1,8),PKW(pB1,10),PKW(pB1,12),PKW(pB1,14)};
    SBAR(); pv(o,vb0+sl_cur,PAF(0),PAF(1),PAF(2),PAF(3)); }
  #undef PKW
  #undef PAF
  #undef VFR
  #undef PIN
  #undef MX3
  #undef GAPA
  #undef GAPB
  #undef EX
  #undef VRD
  #undef KRD
  #undef STEP
  #undef ENDW
  {auto rr=__builtin_amdgcn_permlane32_swap(__float_as_uint(l_reg),__float_as_uint(l_reg),false,false);l_out=__uint_as_float(rr[0])+__uint_as_float(rr[1]);}
  #undef KT
  #undef NBV
  #undef BIAS
  #undef DMA_K
  #undef DMA_V
  #undef CMASK
  #undef START
  #undef RESC
  #undef ROT
}
template<int THRL> __device__ __forceinline__ void attn_unit(int kind,int stream,int c,const bf16*proj,const unsigned*sel,bf16*mix,float*Dbuf,float lam,char*shm){
  const int b=stream>>3;
  const long rowb=(long)b*SEQ;
  int qcol,kcol,vcol,ocol,sexp; unsigned sm=0xffffffffu;
  if(kind==0){ const int h=stream&7; qcol=h*64; kcol=512+h*64; vcol=1024+h*64; ocol=h*64; sexp=h+1; sm=sel[(rowb+c*QB+(threadIdx.x>>6)*QBLK+(threadIdx.x&31))*8+h]; }
  else { const int hd=(stream>>1)&3, vh=stream&1; qcol=1536+hd*128; kcol=2048+hd*128; vcol=2560+hd*128+vh*64; ocol=hd*128+vh*64; sexp=2*(hd+1); }
  #pragma unroll 1
  for(int mp=0;mp<=kind;++mp){
    f32x16 o[2]; float l;
    attn_core<THRL>(c,proj+(rowb+c*QB+(threadIdx.x>>6)*QBLK)*DM+qcol+mp*64,proj+rowb*DM+kcol+mp*64,proj+rowb*DM+vcol,sm,sexp,shm,o,l);
    int tid2=threadIdx.x; asm volatile("":"+v"(tid2)); const int lane=tid2&63,r32=lane&31,hi=lane>>5; const int wid=__builtin_amdgcn_readfirstlane(tid2>>6);
    const long row0=rowb+c*QB+wid*QBLK;
    float*wsf=(float*)(shm+LDS_WS)+wid*64;
    float*stash=(float*)(shm+LDS_STASH)+wid*2048;
    if(hi==0)wsf[32+r32]=l; asm volatile("s_waitcnt lgkmcnt(0)":::"memory");
    float rli[16];
    #pragma unroll
    for(int r=0;r<16;++r)rli[r]=__builtin_amdgcn_rcpf(wsf[32+crow(r,hi)]);
    if(kind==0){
      bf16*Ow=mix+row0*1024+ocol; bf16*stg=(bf16*)(shm+LDS_OST)+wid*2048;
      #pragma unroll
      for(int r=0;r<16;r+=1){const int orow=crow(r,hi);
        #pragma unroll
        for(int d0=0;d0<2;++d0)stg[orow*64+d0*32+r32]=(bf16)(cvtpk_s(o[d0][r]*rli[r],0.f)&0xffffu);}
      asm volatile("s_waitcnt lgkmcnt(0)":::"memory");
      #pragma unroll
      for(int i=0;i<4;++i){const int row=i*8+(lane>>3),ch=lane&7; const u32x4 v=*(const u32x4*)(stg+row*64+ch*8); ATTN_STORE16(Ow+(long)row*1024+ch*8,v);}
    } else if(mp==0){
      #pragma unroll
      for(int d0=0;d0<2;++d0)
        #pragma unroll
        for(int r=0;r<16;++r)stash[(d0*16+r)*64+lane]=o[d0][r]*rli[r];
    } else {
      #pragma unroll
      for(int d0=0;d0<2;++d0)
        #pragma unroll
        for(int r=0;r<16;++r)o[d0][r]=stash[(d0*16+r)*64+lane]-lam*(o[d0][r]*rli[r]);
      asm volatile("s_waitcnt lgkmcnt(0)":::"memory");
      #pragma unroll
      for(int r=0;r<16;++r){const int orow=crow(r,hi);
        #pragma unroll
        for(int d0=0;d0<2;++d0)stash[orow*64+d0*32+r32]=o[d0][r];}
      asm volatile("s_waitcnt lgkmcnt(0)":::"memory");
      float*Dw=Dbuf+row0*512+ocol;
      #pragma unroll
      for(int i=0;i<8;++i){const int row=i*4+(lane>>4),ch=lane&15; const f32x4_t v=*(const f32x4_t*)(stash+row*64+ch*4); *(f32x4_t*)(Dw+(long)row*512+ch*4)=v;}
    }
    asm volatile("s_waitcnt lgkmcnt(0)\n\ts_barrier":::"memory");
  }
}
constexpr int ATTN_LDS_BYTES=LDS_BYTES;
template<int THRL=8> __device__ __forceinline__ void attn_phase(char*lds,const bf16*proj,const unsigned*sel,bf16*mix,float*Dbuf,float lam,int vcu){
  const int stream=vcu>>2, s=vcu&3;
  #pragma unroll 1
  for(int u=0;u<8;++u){ const int i=u&3, c=(i==0)?s:(i==1)?15-s:(i==2)?4+s:11-s;
    attn_unit<THRL>(u<4?1:0,stream,c,proj,sel,mix,Dbuf,lam,lds); }
}
#undef SBAR
#undef WAIT_BAR
}
#define GAS __attribute__((address_space(1)))
#define LAS __attribute__((address_space(3)))
typedef unsigned short bf16;
typedef unsigned v4u __attribute__((ext_vector_type(4)));
typedef float f32x4 __attribute__((ext_vector_type(4)));
typedef short bf16x8 __attribute__((ext_vector_type(8)));
typedef GAS unsigned gu32;
typedef GAS unsigned long long gu64;
#define RLX_AGENT __ATOMIC_RELAXED, __HIP_MEMORY_SCOPE_AGENT
#define LDS_WAIT() asm volatile("s_waitcnt lgkmcnt(0)" ::: "memory")
#define VM_WAIT() asm volatile("s_waitcnt vmcnt(0)" ::: "memory")
__device__ __forceinline__ unsigned long long rt() { return __builtin_amdgcn_s_memrealtime(); }
__device__ __forceinline__ unsigned f2bf(float f) { unsigned u = __builtin_bit_cast(unsigned, f); return (u + 0x7fffu + ((u >> 16) & 1u)) >> 16; }
__device__ __forceinline__ unsigned pk2(float lo, float hi) { return f2bf(lo) | (f2bf(hi) << 16); }

#define XB_TMO      128
#define XB_XCNT(j)  (256  + 64 * (j))
#define XB_XSUB(j)  (1280 + 64 * (j))
#define XB_XGEN(j)  (2304 + 64 * (j))
#define XB_TOP      3328
#define XB_TOPGEN   3392
#define XCD_BAR_WORDS 3456
#define XB_SPIN_CAP (1u << 22)

__device__ __forceinline__ unsigned xb_ld(unsigned* p)              { return __hip_atomic_load(p, __ATOMIC_RELAXED, __HIP_MEMORY_SCOPE_AGENT); }
__device__ __forceinline__ unsigned xb_add(unsigned* p, unsigned v) { return __hip_atomic_fetch_add(p, v, __ATOMIC_RELAXED, __HIP_MEMORY_SCOPE_AGENT); }
__device__ __forceinline__ unsigned xb_xcc_id() { return (unsigned)__builtin_amdgcn_s_getreg((3 << 11) | 20) & 0xFu; }
#define XB_SPIN(cond, bar) do { unsigned _sp = 0; while (cond) { __builtin_amdgcn_s_sleep(1); \
    if ((++_sp & 255u) == 0u) { if (xb_ld(&(bar)[XB_TMO])) break; if (_sp > XB_SPIN_CAP) { atomicAdd(&(bar)[XB_TMO], 1u); break; } } } } while (0)

struct XcdBarrier {
    unsigned* bar; unsigned x;
    volatile LAS unsigned* st;
};

__device__ __forceinline__ XcdBarrier xcd_barrier_post(unsigned* bar, volatile LAS unsigned* st) {
    XcdBarrier b; b.bar = bar; b.x = xb_xcc_id(); b.st = st;
    if (threadIdx.x == 0) (void)xb_add(&bar[XB_XCNT(b.x)], 1u);
    return b;
}
__device__ __forceinline__ void xcd_barrier_complete(unsigned* bar, unsigned x, unsigned& nloc, unsigned& nx) {
    const unsigned G = gridDim.x * gridDim.y * gridDim.z;
    unsigned sum, cnt, mine, sp = 0u;
    for (;;) {
        sum = 0u; cnt = 0u; mine = 0u;
#pragma unroll
        for (unsigned j = 0; j < 16; ++j) { const unsigned c = xb_ld(&bar[XB_XCNT(j)]); sum += c; cnt += (c > 0u) ? 1u : 0u; mine = (j == x) ? c : mine; }
        if (sum == G) break;
        __builtin_amdgcn_s_sleep(1);
        if ((++sp & 255u) == 0u) { if (xb_ld(&bar[XB_TMO])) break; if (sp > XB_SPIN_CAP) { atomicAdd(&bar[XB_TMO], 1u); break; } }
    }
    nloc = mine > 0u ? mine : 1u; nx = cnt > 0u ? cnt : 1u;
}

__device__ __forceinline__ void xcd_barrier(const XcdBarrier& b) {
    asm volatile("s_waitcnt vmcnt(0)" ::: "memory");
    __syncthreads();
    if (threadIdx.x == 0) {
        unsigned* bar = b.bar;
        __builtin_amdgcn_s_waitcnt(0);
        unsigned nloc = b.st[0], nx = b.st[1];
        if (nloc == 0u) { xcd_barrier_complete(bar, b.x, nloc, nx); b.st[0] = nloc; b.st[1] = nx; }
        const unsigned old = xb_add(&bar[XB_XSUB(b.x)], 1u);
        const unsigned gen = old / nloc;
        if (old + 1u == (gen + 1u) * nloc) {
            __builtin_amdgcn_fence(__ATOMIC_RELEASE, "agent");
            asm volatile("s_waitcnt vmcnt(0)" ::: "memory");
            const unsigned og = xb_add(&bar[XB_TOP], 1u);
            const unsigned tg = og / nx;
            if (og + 1u == (tg + 1u) * nx) xb_add(&bar[XB_TOPGEN], 1u);
            else XB_SPIN(xb_ld(&bar[XB_TOPGEN]) == tg, bar);
            __builtin_amdgcn_fence(__ATOMIC_ACQUIRE, "agent");
            xb_add(&bar[XB_XGEN(b.x)], 1u);
            asm volatile("s_waitcnt vmcnt(0)" ::: "memory");
        } else {
            XB_SPIN(xb_ld(&bar[XB_XGEN(b.x)]) == gen, bar);
            __builtin_amdgcn_fence(__ATOMIC_ACQUIRE, "agent");
            asm volatile("s_waitcnt vmcnt(0)" ::: "memory");
        }
    }
    __syncthreads();
}

constexpr int BATCH = 8, SEQ = 4096, DM = 1024, DEPTH = 2, FF = 2816, NGU = 2 * FF, INW = 3072;
constexpr int M = BATCH * SEQ;
constexpr int NHM = 8, NHD = 4;
constexpr int MIXW = 1024, DW = 512;
constexpr float RMS_EPS = 1e-6f;
constexpr float LOG2E = 1.4426950408889634f;
constexpr float C2 = 0.125f * LOG2E;
constexpr int PC_QM = 0, PC_KM = 512, PC_VM = 1024, PC_QD = 1536, PC_KD = 2048, PC_VD = 2560;
constexpr int PH_PER_LAYER = 13, NPHASE = 1 + DEPTH * PH_PER_LAYER;

constexpr size_t MiB = 1u << 20;
constexpr size_t WS_CTL = 0, CTL_ZERO_BYTES = 1 * MiB;
constexpr size_t WS_KMEAN = 1 * MiB;
constexpr size_t WS_SEL = 2 * MiB;
constexpr size_t WS_W = 4 * MiB, W_LAYER = 41 * MiB;
constexpr size_t W_GU1 = 0, W_DN1 = 11 * MiB, W_IN = W_DN1 + 11 * MiB / 2, W_OUT = W_IN + 6 * MiB, W_GU2 = W_OUT + 2 * MiB, W_DN2 = W_GU2 + 11 * MiB;
static_assert(W_DN2 + 11 * MiB / 2 == W_LAYER, "weight map");
constexpr size_t WS_H = 88 * MiB;
constexpr size_t WS_Y = 152 * MiB;
constexpr size_t WS_BIG = 280 * MiB;
constexpr size_t WS_END = 472 * MiB;
static_assert(WS_W + DEPTH * W_LAYER <= WS_H && WS_H + (size_t)M * DM * 2 <= WS_Y && WS_Y + (size_t)M * DM * 4 <= WS_BIG && WS_BIG + (size_t)M * INW * 2 <= WS_END, "d_ws map");
constexpr int CW_TMO = 0, CW_CODE = 1, CW_BAR = 4096;

constexpr int RING_OFF = 0, SCRATCH_BYTES = 153600;
constexpr int LDSCTL_OFF = SCRATCH_BYTES, MISC_OFF = LDSCTL_OFF + 320;
constexpr int LDS_BYTES = 155648;
static_assert(MISC_OFF + 128 <= LDS_BYTES && attn_body::ATTN_LDS_BYTES <= SCRATCH_BYTES, "LDS map");
constexpr int NWAVES = 8;

__device__ __forceinline__ float bf2f(unsigned u) { return __uint_as_float(u << 16); }
__device__ __forceinline__ float wave_sum(float v) {
#pragma unroll
    for (int o = 1; o < 64; o <<= 1) v += __shfl_xor(v, o);
    return v;
}
__device__ __forceinline__ float dot4(f32x4 a, f32x4 b) { return (a.x * b.x + a.y * b.y) + (a.z * b.z + a.w * b.w); }

__device__ __forceinline__ void transpose_item(const float* W, int K, int N, bf16* WT, int kb, int nb, int dstrow0, LAS float* scr, int lane) {
    const int k0 = 64 * kb, n0 = 32 * nb;
#pragma unroll 8
    for (int i = 0; i < 32; ++i) { const int kk = 2 * i + (lane >> 5); scr[kk * 33 + (lane & 31)] = W[(size_t)(k0 + kk) * N + n0 + (lane & 31)]; }
    LDS_WAIT(); asm volatile("" ::: "memory");
    const int c = lane & 7;
#pragma unroll
    for (int j = 0; j < 4; ++j) { const int n = (lane >> 3) + 8 * j; const LAS float* s = scr + (8 * c) * 33 + n;
        v4u o; o.x = pk2(s[0 * 33], s[1 * 33]); o.y = pk2(s[2 * 33], s[3 * 33]); o.z = pk2(s[4 * 33], s[5 * 33]); o.w = pk2(s[6 * 33], s[7 * 33]);
        *(GAS v4u*)(WT + (size_t)(dstrow0 + n0 + n) * K + k0 + 8 * c) = o; }
    LDS_WAIT(); asm volatile("" ::: "memory");
}
__device__ __forceinline__ void rms_row_to_bf16(const float* xrow, const float* g, bf16* orow, int lane) {
    const GAS f32x4* xr = (const GAS f32x4*)xrow + lane; const GAS f32x4* gr = (const GAS f32x4*)g + lane;
    f32x4 v[4]; float s = 0.f;
#pragma unroll
    for (int j = 0; j < 4; ++j) { v[j] = xr[64 * j]; s += dot4(v[j], v[j]); }
    const float r = 1.f / sqrtf(wave_sum(s) * (1.f / DM) + RMS_EPS);
    GAS unsigned long long* o8 = (GAS unsigned long long*)orow + lane;
#pragma unroll
    for (int j = 0; j < 4; ++j) { const f32x4 gg = gr[64 * j]; const f32x4 h = v[j] * gg * r;
        o8[64 * j] = (unsigned long long)pk2(h.x, h.y) | ((unsigned long long)pk2(h.z, h.w) << 32); }
}
struct Args { const float* in[20]; float* out; unsigned char* ws; int ph_lo, ph_hi, li, pad; };
constexpr int ITEMS_FFW = 16 * 88, ITEMS_DNW = 44 * 32, ITEMS_INW = 16 * 96, ITEMS_OUTW = 16 * 32;
constexpr int ITEMS_LAYER = 4 * ITEMS_FFW + 2 * ITEMS_DNW + ITEMS_INW + ITEMS_OUTW;
typedef const __attribute__((address_space(4))) Args* kargs_t0;
__device__ __forceinline__ void prologue_phase(kargs_t0 Pq, LAS unsigned char* lds, int gw, int NGW, int wave, int lane) {
    LAS float* scr = (LAS float*)(lds + RING_OFF + wave * 16384);
    for (int it = gw; it < DEPTH * ITEMS_LAYER; it += NGW) {
        const int l = it / ITEMS_LAYER; int r = it % ITEMS_LAYER;
        unsigned char* wl = Pq->ws + WS_W + (size_t)l * W_LAYER;
        const size_t offF = (size_t)l * DM * FF, offI = (size_t)l * DM * INW, offO = (size_t)l * DM * DM;
        if (r < 2 * ITEMS_FFW) { const int up = r >= ITEMS_FFW; if (up) r -= ITEMS_FFW; const int kb = r / 88, nb = r % 88, n0 = 32 * nb;
            transpose_item((up ? Pq->in[3] : Pq->in[2]) + offF, DM, FF, (bf16*)(wl + W_GU1), kb, nb, 256 * (n0 >> 7) + (n0 & 127) + up * 128 - n0, scr, lane); continue; }
        r -= 2 * ITEMS_FFW;
        if (r < ITEMS_DNW) { transpose_item(Pq->in[4] + offF, FF, DM, (bf16*)(wl + W_DN1), r / 32, r % 32, 0, scr, lane); continue; }
        r -= ITEMS_DNW;
        if (r < ITEMS_INW) { transpose_item(Pq->in[7] + offI, DM, INW, (bf16*)(wl + W_IN), r / 96, r % 96, 0, scr, lane); continue; }
        r -= ITEMS_INW;
        if (r < ITEMS_OUTW) { transpose_item(Pq->in[13] + offO, DM, DM, (bf16*)(wl + W_OUT), r / 32, r % 32, 0, scr, lane); continue; }
        r -= ITEMS_OUTW;
        if (r < 2 * ITEMS_FFW) { const int up = r >= ITEMS_FFW; if (up) r -= ITEMS_FFW; const int kb = r / 88, nb = r % 88, n0 = 32 * nb;
            transpose_item((up ? Pq->in[17] : Pq->in[16]) + offF, DM, FF, (bf16*)(wl + W_GU2), kb, nb, 256 * (n0 >> 7) + (n0 & 127) + up * 128 - n0, scr, lane); continue; }
        r -= 2 * ITEMS_FFW;
        transpose_item(Pq->in[18] + offF, FF, DM, (bf16*)(wl + W_DN2), r / 32, r % 32, 0, scr, lane);
    }
    bf16* H = (bf16*)(Pq->ws + WS_H);
    for (int m = gw; m < M; m += NGW) rms_row_to_bf16(Pq->in[0] + (size_t)m * DM, Pq->in[1], H + (size_t)m * DM, lane);
}
__device__ __forceinline__ void ew_phase(const float* xsrc, const float* Y, float* xdst, float coef, const float* gpost, const float* gnext, bf16* H, int gw, int NGW, int lane) {
    for (int r = gw; r < M; r += NGW) {
        const GAS f32x4* xr = (const GAS f32x4*)(xsrc + (size_t)r * DM) + lane; const GAS f32x4* yr = (const GAS f32x4*)(Y + (size_t)r * DM) + lane;
        const GAS f32x4* g1 = (const GAS f32x4*)gpost + lane;
        f32x4 xv[4], yv[4]; float s = 0.f;
#pragma unroll
        for (int j = 0; j < 4; ++j) { yv[j] = yr[64 * j]; xv[j] = xr[64 * j]; s += dot4(yv[j], yv[j]); }
        const float r1 = coef / sqrtf(wave_sum(s) * (1.f / DM) + RMS_EPS);
        float s2 = 0.f; GAS f32x4* xo = (GAS f32x4*)(xdst + (size_t)r * DM) + lane;
#pragma unroll
        for (int j = 0; j < 4; ++j) { xv[j] = xv[j] + yv[j] * g1[64 * j] * r1; s2 += dot4(xv[j], xv[j]); xo[64 * j] = xv[j]; }
        if (gnext) {
            const float r2 = 1.f / sqrtf(wave_sum(s2) * (1.f / DM) + RMS_EPS);
            const GAS f32x4* g2 = (const GAS f32x4*)gnext + lane; GAS unsigned long long* o8 = (GAS unsigned long long*)(H + (size_t)r * DM) + lane;
#pragma unroll
            for (int j = 0; j < 4; ++j) { const f32x4 h = xv[j] * g2[64 * j] * r2; o8[64 * j] = (unsigned long long)pk2(h.x, h.y) | ((unsigned long long)pk2(h.z, h.w) << 32); }
        }
    }
}
__device__ __forceinline__ void kmean_phase(const bf16* proj, float* kmean, LAS float* scr, int vcu, int G, int tid) {
    for (int it = vcu; it < BATCH * 16; it += G) {
        const int b = it >> 4, blk = it & 15, cp = tid & 255, rh = tid >> 8;
        const bf16* p = proj + ((size_t)b * SEQ + blk * 256 + rh * 128) * INW + PC_KM + cp * 2;
        float s0 = 0.f, s1 = 0.f;
#pragma unroll 8
        for (int i = 0; i < 128; ++i) { const unsigned w = *(const GAS unsigned*)(p + (size_t)i * INW); s0 += bf2f(w & 0xffffu); s1 += bf2f(w >> 16); }
        if (rh == 1) { scr[cp * 2] = s0; scr[cp * 2 + 1] = s1; }
        __syncthreads();
        if (rh == 0) { s0 += scr[cp * 2]; s1 += scr[cp * 2 + 1]; const int col = cp * 2, h = col >> 6, d = col & 63;
            float* o = kmean + ((size_t)((b * NHM + h) * 16 + blk)) * 64 + d; o[0] = s0 * (1.f / 256.f); o[1] = s1 * (1.f / 256.f); }
        __syncthreads();
    }
}
__device__ __forceinline__ void gate_phase(const bf16* proj, const float* kmean, unsigned* sel, int vcu, int G, int tid) {
    for (int idx = vcu * 512 + tid; idx < M * NHM; idx += G * 512) {
        const int t = idx >> 3, h = idx & 7, b = t >> 12, c = (t & 4095) >> 8;
        unsigned mask;
        if (c <= 3) mask = (1u << c) - 1u;
        else {
            f32x4 q[16];
            const GAS v4u* qp = (const GAS v4u*)(proj + (size_t)t * INW + PC_QM + h * 64);
#pragma unroll
            for (int i = 0; i < 8; ++i) { const v4u w = qp[i]; q[2 * i] = (f32x4){bf2f(w.x & 0xffffu), bf2f(w.x >> 16), bf2f(w.y & 0xffffu), bf2f(w.y >> 16)};
                q[2 * i + 1] = (f32x4){bf2f(w.z & 0xffffu), bf2f(w.z >> 16), bf2f(w.w & 0xffffu), bf2f(w.w >> 16)}; }
            const GAS f32x4* km = (const GAS f32x4*)(kmean + (size_t)(b * NHM + h) * 16 * 64);
            float v0 = -INFINITY, v1 = -INFINITY, v2 = -INFINITY; int i0 = 0, i1 = 0, i2 = 0;
#pragma unroll 1
            for (int j = 0; j < c; ++j) { float s = 0.f;
#pragma unroll
                for (int i = 0; i < 16; ++i) s += dot4(q[i], km[j * 16 + i]);
                if (s > v0) { v2 = v1; i2 = i1; v1 = v0; i1 = i0; v0 = s; i0 = j; }
                else if (s > v1) { v2 = v1; i2 = i1; v1 = s; i1 = j; }
                else if (s > v2) { v2 = s; i2 = j; } }
            mask = (1u << i0) | (1u << i1) | (1u << i2);
        }
        sel[idx] = mask;
    }
}
__device__ __forceinline__ void diffnorm_phase(const float* Dbuf, const float* subg, float osc, bf16* mix, int gw, int NGW, int lane) {
    for (int r = gw; r < M; r += NGW) {
        const GAS f32x4* dr = (const GAS f32x4*)(Dbuf + (size_t)r * DW) + lane;
        const f32x4 a = dr[0], b = dr[64];
        float sa = dot4(a, a), sb = dot4(b, b);
#pragma unroll
        for (int o = 1; o < 32; o <<= 1) { sa += __shfl_xor(sa, o); sb += __shfl_xor(sb, o); }
        const float ra = osc / sqrtf(sa * (1.f / 128.f) + RMS_EPS), rb = osc / sqrtf(sb * (1.f / 128.f) + RMS_EPS);
        const f32x4 g = ((const GAS f32x4*)subg)[lane & 31];
        const f32x4 oa = a * g * ra, ob = b * g * rb;
        GAS unsigned long long* o8 = (GAS unsigned long long*)(mix + (size_t)r * MIXW + DW) + lane;
        o8[0] = (unsigned long long)pk2(oa.x, oa.y) | ((unsigned long long)pk2(oa.z, oa.w) << 32);
        o8[64] = (unsigned long long)pk2(ob.x, ob.y) | ((unsigned long long)pk2(ob.z, ob.w) << 32);
    }
}
__device__ __forceinline__ float lam_init_of(int l) { return l == 0 ? 0.2f : 0.35550907f; }

#if REF_ATTN
__global__ void __launch_bounds__(256) ref_moba(const bf16* proj, const unsigned* sel, bf16* mix) {
    __shared__ float Ks[64][64], Vs[64][64];
    const int bid = blockIdx.x, c = bid & 15, h = (bid >> 4) & 7, b = bid >> 7, tid = threadIdx.x;
    const int qpos = c * 256 + tid; const size_t row = (size_t)b * SEQ + qpos;
    float q[64], o[64];
#pragma unroll
    for (int d = 0; d < 64; ++d) { q[d] = bf2f(proj[row * INW + PC_QM + h * 64 + d]); o[d] = 0.f; }
    const unsigned smask = sel[row * NHM + h];
    const float slope2 = exp2f(-(float)(h + 1)) * LOG2E;
    float m = -INFINITY, l = 0.f;
    for (int j = c; j >= 0; --j) {
        const bool act = (j == c) || ((smask >> j) & 1u);
        for (int kt = 3; kt >= 0; --kt) {
            __syncthreads();
            { const int r = tid >> 2, qd = tid & 3; const bf16* kp = proj + ((size_t)b * SEQ + j * 256 + kt * 64 + r) * INW + h * 64 + qd * 16;
#pragma unroll
              for (int i = 0; i < 16; ++i) { Ks[r][qd * 16 + i] = bf2f(kp[PC_KM + i]); Vs[r][qd * 16 + i] = bf2f(kp[PC_VM + i]); } }
            __syncthreads();
            if (act) for (int k = 63; k >= 0; --k) { const int kpos = j * 256 + kt * 64 + k; if (kpos > qpos) continue;
                float s = 0.f;
#pragma unroll
                for (int d = 0; d < 64; ++d) s += q[d] * Ks[k][d];
                s += slope2 * (float)(kpos - qpos);
                if (s > m) { const float a = exp2f(m - s); l *= a;
#pragma unroll
                    for (int d = 0; d < 64; ++d) o[d] *= a;
                    m = s; }
                const float p = exp2f(s - m); l += p;
#pragma unroll
                for (int d = 0; d < 64; ++d) o[d] += p * Vs[k][d]; }
        }
    }
    const float il = 1.f / l;
#pragma unroll
    for (int d = 0; d < 64; ++d) mix[row * MIXW + h * 64 + d] = (bf16)f2bf(o[d] * il);
}
__global__ void __launch_bounds__(256) ref_diff(const bf16* proj, const float* lq1, const float* lk1, const float* lq2, const float* lk2, float lam_init, float* Dbuf) {
    __shared__ float Ks[64][64], Vs[64][64];
    const int bid = blockIdx.x, c = bid & 15, vh = (bid >> 4) & 1, hd = (bid >> 5) & 3, b = bid >> 7, tid = threadIdx.x;
    const int qpos = c * 256 + tid; const size_t row = (size_t)b * SEQ + qpos;
    float s1 = 0.f, s2 = 0.f;
    for (int i = 0; i < 64; ++i) { s1 += lq1[i] * lk1[i]; s2 += lq2[i] * lk2[i]; }
    const float lam = expf(s1) - expf(s2) + lam_init;
    const float slope2 = exp2f(-2.0f * (float)(hd + 1)) * LOG2E;
    float q[64], o[64], o1[64];
    for (int mp = 0; mp < 2; ++mp) {
#pragma unroll
        for (int d = 0; d < 64; ++d) { q[d] = bf2f(proj[row * INW + PC_QD + hd * 128 + mp * 64 + d]); o[d] = 0.f; }
        float m = -INFINITY, l = 0.f;
        for (int j = c; j >= 0; --j)
            for (int kt = 3; kt >= 0; --kt) {
                __syncthreads();
                { const int r = tid >> 2, qd = tid & 3; const bf16* kp = proj + ((size_t)b * SEQ + j * 256 + kt * 64 + r) * INW;
#pragma unroll
                  for (int i = 0; i < 16; ++i) { Ks[r][qd * 16 + i] = bf2f(kp[PC_KD + hd * 128 + mp * 64 + qd * 16 + i]); Vs[r][qd * 16 + i] = bf2f(kp[PC_VD + hd * 128 + vh * 64 + qd * 16 + i]); } }
                __syncthreads();
                for (int k = 63; k >= 0; --k) { const int kpos = j * 256 + kt * 64 + k; if (kpos > qpos) continue;
                    float s = 0.f;
#pragma unroll
                    for (int d = 0; d < 64; ++d) s += q[d] * Ks[k][d];
                    s += slope2 * (float)(kpos - qpos);
                    if (s > m) { const float a = exp2f(m - s); l *= a;
#pragma unroll
                        for (int d = 0; d < 64; ++d) o[d] *= a;
                        m = s; }
                    const float p = exp2f(s - m); l += p;
#pragma unroll
                    for (int d = 0; d < 64; ++d) o[d] += p * Vs[k][d]; }
            }
        const float il = 1.f / l;
        if (mp == 0) {
#pragma unroll
            for (int d = 0; d < 64; ++d) o1[d] = o[d] * il;
        } else {
#pragma unroll
            for (int d = 0; d < 64; ++d) Dbuf[row * DW + hd * 128 + vh * 64 + d] = o1[d] - lam * (o[d] * il);
        }
    }
}
#endif

__device__ __forceinline__ void scalar_attn_item(int kind, int stream, int pairi, const bf16* proj, const unsigned* sel, bf16* mix, float* Dbuf, float lam, LAS float* Ks, LAS float* Vs, int tid) {
    const int c = 2 * pairi + (tid >> 8), cmax = 2 * pairi + 1, qi = tid & 255;
    int b, qcol, kcol, vcol; float slope2;
    if (kind == 0) { const int h = stream & 7; b = stream >> 3; qcol = PC_QM + h * 64; kcol = PC_KM + h * 64; vcol = PC_VM + h * 64; slope2 = exp2f(-(float)(h + 1)) * LOG2E; }
    else { const int vh = stream & 1, hd = (stream >> 1) & 3; b = stream >> 3; qcol = PC_QD + hd * 128; kcol = PC_KD + hd * 128; vcol = PC_VD + hd * 128 + vh * 64; slope2 = exp2f(-2.0f * (float)(hd + 1)) * LOG2E; }
    const int qpos = c * 256 + qi; const size_t row = (size_t)b * SEQ + qpos;
    const unsigned smask = (kind == 0) ? sel[row * NHM + (stream & 7)] : 0xffffu;
    for (int mp = 0; mp <= kind; ++mp) {
        float q[64], o[64];
#pragma unroll
        for (int d = 0; d < 64; ++d) { q[d] = bf2f(proj[row * INW + qcol + mp * 64 + d]); o[d] = 0.f; }
        float m = -INFINITY, l = 0.f;
        for (int j = cmax; j >= 0; --j) {
            const bool act = (j == c) || (j < c && ((smask >> j) & 1u));
            for (int kt = 3; kt >= 0; --kt) {
                __syncthreads();
                { const int r = tid >> 3, od = tid & 7; const bf16* kp = proj + ((size_t)b * SEQ + j * 256 + kt * 64 + r) * INW;
#pragma unroll
                  for (int i = 0; i < 8; ++i) { Ks[r * 64 + od * 8 + i] = bf2f(kp[kcol + mp * 64 + od * 8 + i]); Vs[r * 64 + od * 8 + i] = bf2f(kp[vcol + od * 8 + i]); } }
                __syncthreads();
                if (act) for (int k = 63; k >= 0; --k) { const int kpos = j * 256 + kt * 64 + k; if (kpos > qpos) continue;
                    float s = 0.f;
#pragma unroll
                    for (int d = 0; d < 64; ++d) s += q[d] * Ks[k * 64 + d];
                    s += slope2 * (float)(kpos - qpos);
                    if (s > m) { const float a = exp2f(m - s); l *= a;
#pragma unroll
                        for (int d = 0; d < 64; ++d) o[d] *= a;
                        m = s; }
                    const float p = exp2f(s - m); l += p;
#pragma unroll
                    for (int d = 0; d < 64; ++d) o[d] += p * Vs[k * 64 + d]; }
            }
        }
        const float il = 1.f / l;
        if (kind == 0) {
#pragma unroll
            for (int d = 0; d < 64; ++d) mix[row * MIXW + (stream & 7) * 64 + d] = (bf16)f2bf(o[d] * il);
        } else { float* dp = Dbuf + row * DW + ((stream >> 1) & 3) * 128 + (stream & 1) * 64;
            if (mp == 0) {
#pragma unroll
                for (int d = 0; d < 64; ++d) dp[d] = o[d] * il;
            } else {
#pragma unroll
                for (int d = 0; d < 64; ++d) dp[d] = dp[d] - lam * (o[d] * il);
            } }
    }
}
__device__ __forceinline__ void scalar_attn_phase(const bf16* proj, const unsigned* sel, bf16* mix, float* Dbuf, float lam, LAS float* scr, int vcu, int G, int tid) {
    for (int it = vcu; it < 1024; it += G) {
        const int kind = it >> 9, r = it & 511, stream = r >> 3, pairi = ((r >> 3) & 1) ? (r & 7) : 7 - (r & 7);
        scalar_attn_item(kind, stream, pairi, proj, sel, mix, Dbuf, lam, scr, scr + 4096, tid);
    }
    __syncthreads();
}

typedef const __attribute__((address_space(4))) Args* kargs_t;
__global__ void __launch_bounds__(NWAVES * 64, 2) mk_fwd(Args args_unused) {
    extern __shared__ __attribute__((aligned(16))) unsigned char lds[];
    LAS unsigned char* L = (LAS unsigned char*)lds;
    volatile LAS unsigned* MISC = (volatile LAS unsigned*)(L + MISC_OFF);
    for (int u = threadIdx.x; u < (LDS_BYTES - LDSCTL_OFF) / 4; u += NWAVES * 64) ((LAS unsigned*)(L + LDSCTL_OFF))[u] = 0u;
    __syncthreads();
    kargs_t ap0 = (kargs_t)__builtin_amdgcn_kernarg_segment_ptr();
    const int lo = ap0->ph_lo, hi = ap0->ph_hi;
    XcdBarrier bar; bar.bar = (unsigned*)((gu32*)(ap0->ws + WS_CTL) + CW_BAR) + ap0->li * XCD_BAR_WORDS; bar.x = 0; bar.st = MISC + 8;
    if (hi - lo > 1) bar = xcd_barrier_post(bar.bar, MISC + 8);

    for (int ph = lo; ph < hi; ++ph) {
        if (ph > lo) xcd_barrier(bar);
        kargs_t P = (kargs_t)__builtin_amdgcn_kernarg_segment_ptr(); asm volatile("" : "+s"(P));
        int tid = threadIdx.x; asm volatile("" : "+v"(tid));
        const int lane = tid & 63, wave = __builtin_amdgcn_readfirstlane(tid >> 6);
        int G = gridDim.x, bx = blockIdx.x; asm volatile("" : "+s"(G), "+s"(bx));
        const int vcu = (G % 8 == 0) ? (bx % 8) * (G / 8) + bx / 8 : bx;
        const int gw = vcu * NWAVES + wave, NGW = G * NWAVES;
        unsigned char* ws = P->ws;
        bf16* H = (bf16*)(ws + WS_H); float* Y = (float*)(ws + WS_Y); float* Dbuf = (float*)(ws + WS_Y);
        bf16* BIG = (bf16*)(ws + WS_BIG); float* kmean = (float*)(ws + WS_KMEAN); unsigned* sel = (unsigned*)(ws + WS_SEL);
        if (ph == 0) { prologue_phase(P, L, gw, NGW, wave, lane); continue; }
        const int l = (ph - 1) / PH_PER_LAYER, k = (ph - 1) % PH_PER_LAYER;
        unsigned char* wl = ws + WS_W + (size_t)l * W_LAYER;
        if (k == 0 || k == 10) {
            pg8::Gemm g{H, (const bf16*)(wl + (k == 0 ? W_GU1 : W_GU2)), M, NGU, DM}; pg8::StaticOrder S; S.init(M, NGU, G, bx);
            pg8::EpiSwiGLU E{BIG, FF};
            pg8::gemm_phase<pg8::EpiSwiGLU, pg8::StaticOrder, true, true>(L + RING_OFF, g, S, E);
        } else if (k == 1 || k == 11) {
            pg8::Gemm g{BIG, (const bf16*)(wl + (k == 1 ? W_DN1 : W_DN2)), M, DM, FF}; pg8::StaticOrder S; S.init(M, DM, G, bx);
            pg8::EpiF32 E{Y, DM};
            pg8::gemm_phase<pg8::EpiF32, pg8::StaticOrder, true, true>(L + RING_OFF, g, S, E);
        } else if (k == 8) {
            pg8::Gemm g{H, (const bf16*)(wl + W_OUT), M, DM, DM}; pg8::StaticOrder S; S.init(M, DM, G, bx);
            pg8::EpiF32 E{Y, DM};
            pg8::gemm_phase<pg8::EpiF32, pg8::StaticOrder, true, true>(L + RING_OFF, g, S, E);
        } else if (k == 3) {
            pg8::Gemm g{H, (const bf16*)(wl + W_IN), M, INW, DM}; pg8::StaticOrder S; S.init(M, INW, G, bx);
            pg8::EpiProj E{BIG, INW, 0xC3u, C2};
            pg8::gemm_phase<pg8::EpiProj, pg8::StaticOrder, true, true>(L + RING_OFF, g, S, E);
        } else if (k == 2 || k == 9 || k == 12) {
            const float* xsrc = (l == 0 && k == 2) ? P->in[0] : P->out;
            const float coef = (k == 9) ? 1.0f : 0.5f;
            const float* gpost = (k == 2 ? P->in[5] : k == 9 ? P->in[14] : P->in[19]) + (size_t)l * DM;
            const float* gnext = (k == 2) ? P->in[6] + (size_t)l * DM : (k == 9) ? P->in[15] + (size_t)l * DM : (l + 1 < DEPTH ? P->in[1] + (size_t)(l + 1) * DM : nullptr);
            ew_phase(xsrc, Y, P->out, coef, gpost, gnext, H, gw, NGW, lane);
        } else if (k == 4) {
            kmean_phase(BIG, kmean, (LAS float*)(L + RING_OFF), vcu, G, tid);
        } else if (k == 5) {
            gate_phase(BIG, kmean, sel, vcu, G, tid);
        } else if (k == 6) {
#if !REF_ATTN
            float s1 = 0.f, s2 = 0.f;
            for (int i = 0; i < 64; ++i) { s1 += P->in[8][l * 64 + i] * P->in[9][l * 64 + i]; s2 += P->in[10][l * 64 + i] * P->in[11][l * 64 + i]; }
            const float lam = expf(s1) - expf(s2) + lam_init_of(l);
#if ATTN_IMPL == 1
            if (G == 256) attn_body::attn_phase<8>((char*)lds + RING_OFF, (const attn_body::bf16*)BIG, sel, (attn_body::bf16*)H, Dbuf, lam, vcu);
#else
            scalar_attn_phase(BIG, sel, H, Dbuf, lam, (LAS float*)(L + RING_OFF), vcu, G, tid);
#endif
#endif
        } else if (k == 7) {
            diffnorm_phase(Dbuf, P->in[12] + (size_t)l * 128, 1.0f - lam_init_of(l), H, gw, NGW, lane);
        }
    }
}

extern "C" void kernel_launch(void* const* d_in, const int* in_sizes, int n_in, void* d_out, int out_size, void* d_ws, size_t ws_size, hipStream_t stream) {
    static int grid = 0;
    if (grid == 0) {
        if (n_in != 20 || in_sizes[0] != M * DM || out_size != M * DM || ws_size < WS_END) { fprintf(stderr, "kernel_launch: unexpected shapes (n_in %d, in0 %d, out %d, ws %zu); nothing launched\n", n_in, n_in > 0 ? in_sizes[0] : -1, out_size, ws_size); grid = -1; return; }
        int dev = 0, cus = 0;
        if (hipGetDevice(&dev) != hipSuccess || hipDeviceGetAttribute(&cus, hipDeviceAttributeMultiprocessorCount, dev) != hipSuccess) { grid = -1; return; }
        if (hipFuncSetAttribute((const void*)mk_fwd, hipFuncAttributeMaxDynamicSharedMemorySize, LDS_BYTES) != hipSuccess) { fprintf(stderr, "kernel_launch: hipFuncSetAttribute failed\n"); grid = -1; return; }
        (void)hipGetLastError();
        grid = cus;
    }
    if (grid < 0) return;
    (void)hipMemsetAsync((char*)d_ws + WS_CTL, 0, CTL_ZERO_BYTES, stream);
    Args a{};
    for (int i = 0; i < 20; ++i) a.in[i] = (const float*)d_in[i];
    a.out = (float*)d_out; a.ws = (unsigned char*)d_ws;
#if N_LAUNCH_MODE == 1
    a.ph_lo = 0; a.ph_hi = NPHASE; a.li = 0;
    hipLaunchKernelGGL(mk_fwd, dim3(grid), dim3(NWAVES * 64), LDS_BYTES, stream, a);
#else
    for (int ph = 0; ph < NPHASE; ++ph) {
        a.ph_lo = ph; a.ph_hi = ph + 1; a.li = 0;
#if REF_ATTN
        if (ph >= 1 && (ph - 1) % PH_PER_LAYER == 6) {
            const int l = (ph - 1) / PH_PER_LAYER; unsigned char* ws = (unsigned char*)d_ws;
            hipLaunchKernelGGL(ref_moba, dim3(BATCH * NHM * 16), dim3(256), 0, stream, (const bf16*)(ws + WS_BIG), (const unsigned*)(ws + WS_SEL), (bf16*)(ws + WS_H));
            hipLaunchKernelGGL(ref_diff, dim3(BATCH * NHD * 2 * 16), dim3(256), 0, stream, (const bf16*)(ws + WS_BIG), (const float*)d_in[8] + l * 64, (const float*)d_in[9] + l * 64,
                               (const float*)d_in[10] + l * 64, (const float*)d_in[11] + l * 64, l == 0 ? 0.2f : 0.35550907f, (float*)(ws + WS_Y));
            continue;
        }
#endif
        hipLaunchKernelGGL(mk_fwd, dim3(grid), dim3(NWAVES * 64), LDS_BYTES, stream, a);
    }
#endif
}
```

```cpp
#include <hip/hip_runtime.h>
#include <cstdio>
#include <cstdint>
#include <cmath>
#ifndef N_LAUNCH_MODE
#define N_LAUNCH_MODE 1
#endif
namespace pg8 {
#define PG8_LAS __attribute__((address_space(3)))
typedef unsigned short bf16_t;
typedef short bf16x8 __attribute__((ext_vector_type(8)));
typedef float f32x4 __attribute__((ext_vector_type(4)));
typedef unsigned u32x4 __attribute__((ext_vector_type(4)));
constexpr int BM = 256, BK = 64, HALF = 128, HTB = HALF * BK * 2  , STAGE_BYTES = 8 * HTB, NXCD = 8, WGM = 8;

__host__ __device__ __forceinline__ int lds_byte(int r, int c) { const int st = (r >> 4) * 2 + (c >> 5), rr = r & 15, cc = c & 31, ob = rr * 64 + cc * 2; return st * 1024 + (ob ^ (((ob >> 9) & 1) << 5)); }
__host__ __device__ __forceinline__ void stage_rc(int b, int& R, int& C) { const int st = b / 1024, sb = b % 1024, swz = sb ^ (((sb >> 9) & 1) << 5); R = (st >> 1) * 16 + swz / 64; C = (st & 1) * 32 + (swz % 64) / 2; }
__host__ __device__ __forceinline__ int perm32(int rho) { const int n = rho >> 4, i = rho & 15; return 8 * (i >> 2) + 4 * n + (i & 3); }

struct Unit { int pm, pn; };
struct Gemm { const bf16_t* A; const bf16_t* Bt; int M, N, K; };

struct StaticOrder {
    int nM, nN, nwg, G, c;
    __host__ __device__ void init(int M, int N, int G_, int c_) { nM = M / BM; nN = N / BM; nwg = nM * nN; G = G_; c = c_; }
    __host__ __device__ bool next(int i, Unit& u) const {
        const long L = (long)i * G + c; if (L >= nwg) return false;
        int wgid = (int)L; { const int q = nwg / NXCD, r = nwg % NXCD, xcd = wgid % NXCD, off = wgid / NXCD; wgid = (xcd < r ? xcd * (q + 1) : r * (q + 1) + (xcd - r) * q) + off; }
        const int nig = WGM * nN, gid = wgid / nig, fm = gid * WGM, gsz = (nM - fm) < WGM ? (nM - fm) : WGM;
        u.pm = fm + ((wgid % nig) % gsz); u.pn = (wgid % nig) / gsz; return true;
    }
    __device__ __forceinline__ void a_ready(const Unit&) const {}
    __device__ __forceinline__ void done(const Unit&) const {}
};

__device__ __forceinline__ unsigned cvt_pk_bf16(float lo, float hi) { unsigned r; asm volatile("v_cvt_pk_bf16_f32 %0, %1, %2" : "=v"(r) : "v"(lo), "v"(hi)); return r; }
typedef float f32x2 __attribute__((ext_vector_type(2)));

struct EpiF32 {
    static constexpr bool PERM = false, AFTER_DRAIN = false;
    float* C; int ldc;
    __device__ __forceinline__ void operator()(const f32x4 (&acc)[2][2][4][2], const Unit& u, int wr, int wc, int fr, int fq) const {
        const int row0 = u.pm * BM + wr * 64 + fr, col0 = u.pn * BM + wc * 32 + 4 * fq;
#pragma unroll
        for (int ai = 0; ai < 2; ++ai)
#pragma unroll
            for (int m = 0; m < 4; ++m) { float* rowp = C + (size_t)(row0 + ai * HALF + m * 16) * ldc + col0;
#pragma unroll
                for (int bj = 0; bj < 2; ++bj)
#pragma unroll
                    for (int n = 0; n < 2; ++n) *(f32x4*)(rowp + bj * HALF + n * 16) = acc[ai][bj][m][n]; }
    }
};
struct EpiProj {
    static constexpr bool PERM = true, AFTER_DRAIN = false;
    bf16_t* O; int ldc; unsigned qmask; float qscale; float* ksum;
    __device__ __forceinline__ void operator()(const f32x4 (&acc)[2][2][4][2], const Unit& u, int wr, int wc, int fr, int fq) const {
        const int row0 = u.pm * BM + wr * 64 + fr; const int col0 = u.pn * BM + wc * 32 + 8 * fq;
        const float sc = ((qmask >> u.pn) & 1u) ? qscale : 1.f;
#pragma unroll
        for (int ai = 0; ai < 2; ++ai)
#pragma unroll
            for (int m = 0; m < 4; ++m) { bf16_t* rowp = O + (size_t)(row0 + ai * HALF + m * 16) * ldc + col0;
#pragma unroll
                for (int bj = 0; bj < 2; ++bj) { const f32x4 v0 = acc[ai][bj][m][0] * sc, v1 = acc[ai][bj][m][1] * sc;
                    u32x4 w; w.x = cvt_pk_bf16(v0[0], v0[1]); w.y = cvt_pk_bf16(v0[2], v0[3]); w.z = cvt_pk_bf16(v1[0], v1[1]); w.w = cvt_pk_bf16(v1[2], v1[3]);
                    *(u32x4*)(rowp + bj * HALF) = w; } }
        if (u.pn == 2 || u.pn == 3) {
#pragma unroll
            for (int bj = 0; bj < 2; ++bj)
#pragma unroll
                for (int n = 0; n < 2; ++n) {
                    f32x4 s = acc[0][bj][0][n];
#pragma unroll
                    for (int ai = 0; ai < 2; ++ai)
#pragma unroll
                        for (int m = 0; m < 4; ++m) if (ai | m) s += acc[ai][bj][m][n];
#pragma unroll
                    for (int o = 1; o < 16; o <<= 1) { s.x += __shfl_xor(s.x, o); s.y += __shfl_xor(s.y, o); s.z += __shfl_xor(s.z, o); s.w += __shfl_xor(s.w, o); }
                    if (fr == 0) { const int kc = (u.pn - 2) * BM + bj * HALF + wc * 32 + 8 * fq + 4 * n;
                        float* dst = ksum + ((size_t)(((u.pm >> 4) * 8 + (kc >> 6)) * 16 + (u.pm & 15))) * 64 + (kc & 63);
                        __hip_atomic_fetch_add(dst + 0, s.x, __ATOMIC_RELAXED, __HIP_MEMORY_SCOPE_AGENT); __hip_atomic_fetch_add(dst + 1, s.y, __ATOMIC_RELAXED, __HIP_MEMORY_SCOPE_AGENT);
                        __hip_atomic_fetch_add(dst + 2, s.z, __ATOMIC_RELAXED, __HIP_MEMORY_SCOPE_AGENT); __hip_atomic_fetch_add(dst + 3, s.w, __ATOMIC_RELAXED, __HIP_MEMORY_SCOPE_AGENT); }
                }
        }
    }
};
__device__ __forceinline__ float silu_mul(float g, float u) { const float e = __builtin_amdgcn_exp2f(g * -1.4426950408889634f); return g * __builtin_amdgcn_rcpf(1.0f + e) * u; }
struct EpiSwiGLU {
    static constexpr bool PERM = true, AFTER_DRAIN = false;
    bf16_t* O; int ldc;
    __device__ __forceinline__ void operator()(const f32x4 (&acc)[2][2][4][2], const Unit& u, int wr, int wc, int fr, int fq) const {
        const int row0 = u.pm * BM + wr * 64 + fr; const int col0 = u.pn * HALF + wc * 32 + 8 * fq;
#pragma unroll
        for (int ai = 0; ai < 2; ++ai)
#pragma unroll
            for (int m = 0; m < 4; ++m) { bf16_t* rowp = O + (size_t)(row0 + ai * HALF + m * 16) * ldc + col0;
                const f32x4 g0 = acc[ai][0][m][0], g1 = acc[ai][0][m][1], u0 = acc[ai][1][m][0], u1 = acc[ai][1][m][1];
                u32x4 w;
                w.x = cvt_pk_bf16(silu_mul(g0[0], u0[0]), silu_mul(g0[1], u0[1])); w.y = cvt_pk_bf16(silu_mul(g0[2], u0[2]), silu_mul(g0[3], u0[3]));
                w.z = cvt_pk_bf16(silu_mul(g1[0], u1[0]), silu_mul(g1[1], u1[1])); w.w = cvt_pk_bf16(silu_mul(g1[2], u1[2]), silu_mul(g1[3], u1[3]));
                *(u32x4*)rowp = w; }
    }
};

template <class Epi, class Sched, bool ALIGN_EPI = false, bool SP2 = false>
__device__ __forceinline__ void gemm_phase(PG8_LAS unsigned char* lds, const Gemm g, const Sched& S, const Epi& E) {
    int tid_l = threadIdx.x; asm volatile("" : "+v"(tid_l));
    const int tid = tid_l, wid = __builtin_amdgcn_readfirstlane(tid >> 6), lane = tid & 63, wr = wid >> 2, wc = wid & 3, fr = lane & 15, fq = lane >> 4;
    const int K = g.K, nt = K / BK;
    unsigned voffA[2], voffB[2];
#pragma unroll
    for (int i = 0; i < 2; ++i) { int R, C; stage_rc(tid * 16 + i * 8192, R, C); const int Rb = Epi::PERM ? ((R & ~31) + perm32(R & 31)) : R;
        voffA[i] = (unsigned)(R * K + C) * 2u; voffB[i] = (unsigned)(Rb * K + C) * 2u; }
    const size_t kstep = (size_t)(BK * 2);
    const size_t hstep = (size_t)HALF * K * 2;
    const size_t tstep = 2 * hstep;
    const unsigned ldsw = (unsigned)wid * 1024u;
    const int aoff = lds_byte(wr * 64 + fr, fq * 8), boff = lds_byte(wc * 32 + fr, fq * 8);
#define PG8_SA(b, h) (((b) * 2 + (h)) * HTB)
#define PG8_SB(b, h) ((4 + (b) * 2 + (h)) * HTB)
#define PG8_STAGE(bufoff, gbase, voff) do { _Pragma("unroll") for (int _i = 0; _i < 2; ++_i) \
        __builtin_amdgcn_global_load_lds((const unsigned*)((const char*)(gbase) + (voff)[_i]), (PG8_LAS unsigned*)(lds + (bufoff) + ldsw + _i * 8192), 16, 0, 0); } while (0)
#define PG8_LDA(dst, b, h) do { _Pragma("unroll") for (int m = 0; m < 4; ++m) _Pragma("unroll") for (int k = 0; k < 2; ++k) dst[m][k] = *(const PG8_LAS bf16x8*)(lds + PG8_SA(b, h) + aoff + m * 2048 + k * 1024); } while (0)
#define PG8_LDB(dst, b, h) do { _Pragma("unroll") for (int n = 0; n < 2; ++n) _Pragma("unroll") for (int k = 0; k < 2; ++k) dst[n][k] = *(const PG8_LAS bf16x8*)(lds + PG8_SB(b, h) + boff + n * 2048 + k * 1024); } while (0)
#define PG8_MMA(ai, bj, At, Bt) do { __builtin_amdgcn_s_setprio(1); _Pragma("unroll") for (int m = 0; m < 4; ++m) _Pragma("unroll") for (int n = 0; n < 2; ++n) _Pragma("unroll") for (int k = 0; k < 2; ++k) \
        acc[ai][bj][m][n] = __builtin_amdgcn_mfma_f32_16x16x32_bf16(Bt[n][k], At[m][k], acc[ai][bj][m][n], 0, 0, 0); __builtin_amdgcn_s_setprio(0); } while (0)
#define PG8_WAIT_V(n) asm volatile("s_waitcnt vmcnt(" #n ")" ::: "memory")
#define PG8_WAIT_L(n) asm volatile("s_waitcnt lgkmcnt(" #n ")" ::: "memory")
#define PG8_BAR __builtin_amdgcn_s_barrier()
#define PG8_SCHED __builtin_amdgcn_sched_barrier(0)
    Unit cur, nxt; int ui = 0;
    if (!S.next(0, cur)) return;
    f32x4 acc[2][2][4][2];
#pragma unroll
    for (int a = 0; a < 2; ++a)
#pragma unroll
        for (int b = 0; b < 2; ++b)
#pragma unroll
            for (int m = 0; m < 4; ++m)
#pragma unroll
                for (int n = 0; n < 2; ++n) acc[a][b][m][n] = (f32x4){0.f, 0.f, 0.f, 0.f};
    bf16x8 At[4][2], B0[2][2], B1[2][2];
    const char* cA = (const char*)g.A + (size_t)cur.pm * tstep; const char* cB = (const char*)g.Bt + (size_t)cur.pn * tstep;
    S.a_ready(cur);
    if constexpr (SP2) {
        PG8_STAGE(PG8_SB(0, 0), cB, voffB); PG8_STAGE(PG8_SB(0, 1), cB + hstep, voffB); PG8_STAGE(PG8_SA(0, 0), cA, voffA); PG8_STAGE(PG8_SA(0, 1), cA + hstep, voffA);
        if (wr == 1) PG8_BAR;
        PG8_WAIT_V(2); PG8_BAR;
        PG8_STAGE(PG8_SB(1, 0), cB + kstep, voffB); PG8_STAGE(PG8_SA(1, 0), cA + kstep, voffA); PG8_STAGE(PG8_SB(1, 1), cB + hstep + kstep, voffB);
        PG8_WAIT_V(6); PG8_BAR;
    } else {
        PG8_STAGE(PG8_SB(0, 0), cB, voffB); PG8_STAGE(PG8_SA(0, 0), cA, voffA); PG8_STAGE(PG8_SB(0, 1), cB + hstep, voffB); PG8_STAGE(PG8_SA(0, 1), cA + hstep, voffA);
        if (wr == 1) PG8_BAR;
        PG8_WAIT_V(4); PG8_BAR;
        PG8_STAGE(PG8_SB(1, 0), cB + kstep, voffB); PG8_STAGE(PG8_SA(1, 0), cA + kstep, voffA); PG8_STAGE(PG8_SB(1, 1), cB + hstep + kstep, voffB);
        PG8_WAIT_V(6); PG8_BAR;
    }
    for (;;) {
        const bool has_next = S.next(ui + 1, nxt);
        const char* nA = has_next ? (const char*)g.A + (size_t)nxt.pm * tstep : cA; const char* nB = has_next ? (const char*)g.Bt + (size_t)nxt.pn * tstep : cB;
        for (int t = 0; t < nt; t += 2) {
            const bool last = (t == nt - 2);
            const char* a1 = cA + (size_t)(t + 1) * kstep;
            const char* a2 = last ? nA : cA + (size_t)(t + 2) * kstep; const char* b2 = last ? nB : cB + (size_t)(t + 2) * kstep;
            const char* a3 = a2 + kstep; const char* b3 = b2 + kstep;
            if (last && has_next) S.a_ready(nxt);
            if constexpr (SP2) {
            PG8_LDB(B0, 0, 0); PG8_LDB(B1, 0, 1); PG8_SCHED; PG8_LDA(At, 0, 0); PG8_STAGE(PG8_SA(1, 1), a1 + hstep, voffA);
            PG8_WAIT_V(8); PG8_WAIT_L(0); PG8_BAR; PG8_MMA(0, 0, At, B0); PG8_MMA(0, 1, At, B1); PG8_BAR; PG8_SCHED;
            PG8_LDA(At, 0, 1); PG8_STAGE(PG8_SB(0, 0), b2, voffB); PG8_STAGE(PG8_SB(0, 1), b2 + hstep, voffB); PG8_STAGE(PG8_SA(0, 0), a2, voffA);
            PG8_WAIT_V(8); PG8_WAIT_L(0); PG8_BAR; PG8_MMA(1, 0, At, B0); PG8_MMA(1, 1, At, B1); PG8_BAR; PG8_SCHED;
            PG8_LDB(B0, 1, 0); PG8_LDB(B1, 1, 1); PG8_SCHED; PG8_LDA(At, 1, 0); PG8_STAGE(PG8_SA(0, 1), a2 + hstep, voffA);
            PG8_WAIT_V(8); PG8_WAIT_L(0); PG8_BAR; PG8_MMA(0, 0, At, B0); PG8_MMA(0, 1, At, B1); PG8_BAR; PG8_SCHED;
            PG8_LDA(At, 1, 1); PG8_STAGE(PG8_SB(1, 0), b3, voffB); PG8_STAGE(PG8_SB(1, 1), b3 + hstep, voffB); PG8_STAGE(PG8_SA(1, 0), a3, voffA);
            PG8_WAIT_V(8); PG8_WAIT_L(0); PG8_BAR; PG8_MMA(1, 0, At, B0); PG8_MMA(1, 1, At, B1); PG8_BAR; PG8_SCHED;
            } else {
            PG8_LDB(B0, 0, 0); PG8_SCHED; PG8_LDA(At, 0, 0); PG8_STAGE(PG8_SA(1, 1), a1 + hstep, voffA);
            PG8_WAIT_L(8); PG8_BAR; PG8_WAIT_L(0); PG8_MMA(0, 0, At, B0); PG8_BAR; PG8_SCHED;
            PG8_LDB(B1, 0, 1); PG8_STAGE(PG8_SB(0, 0), b2, voffB);
            PG8_BAR; PG8_WAIT_L(0); PG8_MMA(0, 1, At, B1); PG8_BAR;
            PG8_LDA(At, 0, 1); PG8_STAGE(PG8_SA(0, 0), a2, voffA);
            PG8_BAR; PG8_WAIT_L(0); PG8_MMA(1, 0, At, B0); PG8_BAR; PG8_SCHED;
            PG8_STAGE(PG8_SB(0, 1), b2 + hstep, voffB);
            PG8_WAIT_V(6); PG8_BAR; PG8_MMA(1, 1, At, B1); PG8_BAR;
            PG8_LDB(B0, 1, 0); PG8_SCHED; PG8_LDA(At, 1, 0); PG8_STAGE(PG8_SA(0, 1), a2 + hstep, voffA);
            PG8_WAIT_L(8); PG8_BAR; PG8_WAIT_L(0); PG8_MMA(0, 0, At, B0); PG8_BAR; PG8_SCHED;
            PG8_LDB(B1, 1, 1); PG8_STAGE(PG8_SB(1, 0), b3, voffB);
            PG8_BAR; PG8_WAIT_L(0); PG8_MMA(0, 1, At, B1); PG8_BAR;
            PG8_LDA(At, 1, 1); PG8_STAGE(PG8_SA(1, 0), a3, voffA);
            PG8_BAR; PG8_WAIT_L(0); PG8_MMA(1, 0, At, B0); PG8_BAR; PG8_SCHED;
            PG8_STAGE(PG8_SB(1, 1), b3 + hstep, voffB);
            PG8_WAIT_V(6); PG8_BAR; PG8_MMA(1, 1, At, B1); PG8_BAR;
            }
        }
        if constexpr (ALIGN_EPI) { if (wr == 0) PG8_BAR; }
        if constexpr (!Epi::AFTER_DRAIN) { E(acc, cur, wr, wc, fr, fq); S.done(cur); }
        if (!has_next) break;
#pragma unroll
        for (int a = 0; a < 2; ++a)
#pragma unroll
            for (int b = 0; b < 2; ++b)
#pragma unroll
                for (int m = 0; m < 4; ++m)
#pragma unroll
                    for (int n = 0; n < 2; ++n) acc[a][b][m][n] = (f32x4){0.f, 0.f, 0.f, 0.f};
        cur = nxt; cA = nA; cB = nB; ++ui;
        if constexpr (ALIGN_EPI) { if (wr == 1) PG8_BAR; }
    }
    PG8_WAIT_V(0);
    if constexpr (!ALIGN_EPI) { if (wr == 0) PG8_BAR; }
    PG8_BAR;
    if constexpr (Epi::AFTER_DRAIN) { E.fused(acc, cur, wr, wc, fr, fq, lds, wid, lane); S.done(cur); }
#undef PG8_SA
#undef PG8_SB
#undef PG8_STAGE
#undef PG8_LDA
#undef PG8_LDB
#undef PG8_MMA
#undef PG8_WAIT_V
#undef PG8_WAIT_L
#undef PG8_BAR
#undef PG8_SCHED
}
}
namespace attn_body {
typedef unsigned short bf16;
using bf16x8=__attribute__((ext_vector_type(8)))short;
using s16x4=__attribute__((ext_vector_type(4)))short;
using f32x16=__attribute__((ext_vector_type(16)))float;
using u32x4=__attribute__((ext_vector_type(4)))unsigned;
using f32x4_t=__attribute__((ext_vector_type(4)))float;
constexpr int SEQ=4096,D=64,DM=3072;
constexpr int NW=8,QBLK=32,QB=QBLK*NW,KVBLK=64,NQB=SEQ/QB;
__device__ __forceinline__ int crow(int r,int hi){return (r&3)+8*(r>>2)+4*hi;}
#define SBAR() __builtin_amdgcn_sched_barrier(0)
__device__ __forceinline__ void cmask(f32x16&p0,f32x16&p1,int jb,int qrel,int hi){
  const float NEG=-INFINITY; int kb=64*jb+4*hi;
  #pragma unroll
  for(int r=0;r<16;++r){int kv=kb+(r&3)+8*(r>>2); if(kv>qrel)p0[r]=NEG; if(kv+32>qrel)p1[r]=NEG;}
}

constexpr int NSLOT=3, SLOTB=8192;
constexpr int LDS_K=0, LDS_V=NSLOT*SLOTB, LDS_WS=2*NSLOT*SLOTB, LDS_OST=LDS_WS+NW*64*4, LDS_STASH=LDS_OST+NW*4096, LDS_BYTES=LDS_STASH+NW*8192;
constexpr float C2_unused=0.125f*1.4426950408889634f;
__device__ __forceinline__ void glds16(const void*gsrc,unsigned lds_dst){unsigned keep;
  asm volatile("s_mov_b32 %0, m0\n\ts_mov_b32 m0, %2\n\ts_nop 0\n\tglobal_load_lds_dwordx4 %1, off\n\ts_mov_b32 m0, %0":"=&s"(keep):"v"(gsrc),"s"(lds_dst):"memory");}
__device__ __forceinline__ float max3f(float a,float b,float c){float r;asm("v_max3_f32 %0, %1, %2, %3":"=v"(r):"v"(a),"v"(b),"v"(c));return r;}
__device__ __forceinline__ float max2f(float a,float b){float r;asm("v_max_f32_e32 %0, %1, %2":"=v"(r):"v"(a),"v"(b));return r;}
__device__ __forceinline__ float fadd_s(float a,float b){float r;asm("v_add_f32_e32 %0, %1, %2":"=v"(r):"v"(a),"v"(b));return r;}
__device__ __forceinline__ float fsub_s(float a,float b){float r;asm("v_sub_f32_e32 %0, %1, %2":"=v"(r):"v"(a),"v"(b));return r;}
typedef float f32x2_t __attribute__((ext_vector_type(2))); typedef __bf16 bf16x2_t __attribute__((ext_vector_type(2)));
__device__ __forceinline__ unsigned cvtpk_s(float lo,float hi){f32x2_t v={lo,hi};bf16x2_t b=__builtin_convertvector(v,bf16x2_t);return __builtin_bit_cast(unsigned,b);}
#define WAIT_BAR(N) asm volatile("s_waitcnt vmcnt(" #N ") lgkmcnt(0)\n\ts_barrier":::"memory")

__device__ __forceinline__ void qkt(f32x16&p0,f32x16&p1,const char*Kslot,const bf16x8*qr,const f32x16&negm,int r32,int hi){
  const char*kb=Kslot+hi*1024+r32*16;
  #pragma unroll
  for(int d0=0;d0<4;++d0){
    const bf16x8 b0=*reinterpret_cast<const bf16x8*>(kb+d0*2048);
    const bf16x8 b1=*reinterpret_cast<const bf16x8*>(kb+d0*2048+512);
    if(d0==0){p0=__builtin_amdgcn_mfma_f32_32x32x16_bf16(b0,qr[0],negm,0,0,0);p1=__builtin_amdgcn_mfma_f32_32x32x16_bf16(b1,qr[0],negm,0,0,0);}
    else{p0=__builtin_amdgcn_mfma_f32_32x32x16_bf16(b0,qr[d0],p0,0,0,0);p1=__builtin_amdgcn_mfma_f32_32x32x16_bf16(b1,qr[d0],p1,0,0,0);}}
}
typedef __attribute__((address_space(3))) const char* lds_cptr;
typedef short v4i16_t __attribute__((ext_vector_type(4)));
__device__ __forceinline__ void kload8(bf16x8*kf,lds_cptr kp){
  kf[0]=*(const __attribute__((address_space(3))) bf16x8*)(kp);      kf[1]=*(const __attribute__((address_space(3))) bf16x8*)(kp+512);
  kf[2]=*(const __attribute__((address_space(3))) bf16x8*)(kp+2048); kf[3]=*(const __attribute__((address_space(3))) bf16x8*)(kp+2560);
  kf[4]=*(const __attribute__((address_space(3))) bf16x8*)(kp+4096); kf[5]=*(const __attribute__((address_space(3))) bf16x8*)(kp+4608);
  kf[6]=*(const __attribute__((address_space(3))) bf16x8*)(kp+6144); kf[7]=*(const __attribute__((address_space(3))) bf16x8*)(kp+6656);
}
__device__ __forceinline__ void kload2(bf16x8*kf,lds_cptr kp,int j){ kf[2*j]=*(const __attribute__((address_space(3))) bf16x8*)(kp+j*2048); kf[2*j+1]=*(const __attribute__((address_space(3))) bf16x8*)(kp+j*2048+512); }
__device__ __forceinline__ s16x4 vtr(lds_cptr p){ return __builtin_bit_cast(s16x4,__builtin_amdgcn_ds_read_tr16_b64_v4i16((__attribute__((address_space(3))) v4i16_t*)p)); }
__device__ __forceinline__ float rowmax(const f32x16&p0,const f32x16&p1){
  float a=max3f(p0[0],p0[1],p1[0]),b=max3f(p0[2],p0[3],p1[1]);a=max3f(a,p1[2],p1[3]);
  #pragma unroll
  for(int r=4;r<16;r+=4){a=max3f(a,p0[r],p0[r+1]);b=max3f(b,p0[r+2],p0[r+3]);a=max3f(a,p1[r],p1[r+1]);b=max3f(b,p1[r+2],p1[r+3]);}
  const float m=max2f(a,b);
  auto rr=__builtin_amdgcn_permlane32_swap(__float_as_uint(m),__float_as_uint(m),false,false);
  return max2f(__uint_as_float(rr[0]),__uint_as_float(rr[1]));
}
__device__ __forceinline__ void pv(f32x16*o,int vb,bf16x8 pa0,bf16x8 pa1,bf16x8 pa2,bf16x8 pa3){
  #pragma unroll
  for(int d0=0;d0<2;++d0){s16x4 lo[4],hi[4];
    #pragma unroll
    for(int ks=0;ks<4;++ks){
      asm volatile("ds_read_b64_tr_b16 %0,%1 offset:%c2":"=&v"(lo[ks]):"v"(vb),"i"(d0*4096+ks*1024):"memory");
      asm volatile("ds_read_b64_tr_b16 %0,%1 offset:%c2":"=&v"(hi[ks]):"v"(vb),"i"(d0*4096+ks*1024+512):"memory");}
    asm volatile("s_waitcnt lgkmcnt(0)":::"memory");SBAR();
    #define PK(k) (bf16x8){lo[k][0],lo[k][1],lo[k][2],lo[k][3],hi[k][0],hi[k][1],hi[k][2],hi[k][3]}
    o[d0]=__builtin_amdgcn_mfma_f32_32x32x16_bf16(pa0,PK(0),o[d0],0,0,0);
    o[d0]=__builtin_amdgcn_mfma_f32_32x32x16_bf16(pa1,PK(1),o[d0],0,0,0);
    o[d0]=__builtin_amdgcn_mfma_f32_32x32x16_bf16(pa2,PK(2),o[d0],0,0,0);
    o[d0]=__builtin_amdgcn_mfma_f32_32x32x16_bf16(pa3,PK(3),o[d0],0,0,0);
    #undef PK
  }
}

#ifndef ATTN_STORE16
#define ATTN_STORE16(p,v) (*(u32x4*)(p)=(v))
#endif
__device__ __forceinline__ float sbias(int k,int sexp){ if(k==0)return 0.f; const unsigned bits=__builtin_bit_cast(unsigned,(float)k*1.4426950408889634f); return __builtin_bit_cast(float,(unsigned)__builtin_amdgcn_readfirstlane((int)(bits-((unsigned)sexp<<23)))); }
template<int THRL> __device__ __forceinline__ void attn_core(int c,const bf16*Qw,const bf16*__restrict__ Kh,const bf16*__restrict__ Vh,unsigned selmask,int sexp,char*shm,f32x16(&o)[2],float&l_out){
  const float slope2=sbias(1,sexp);
  int tid_l=threadIdx.x; asm volatile("":"+v"(tid_l)); const int tid=tid_l,lane=tid&63,r32=lane&31,hi=lane>>5; const int wid=__builtin_amdgcn_readfirstlane(tid>>6);
  const unsigned lds0=(unsigned)(uintptr_t)shm;
  float*wsf=(float*)(shm+LDS_WS)+wid*64;
  const bf16*ksrc=Kh+(long)lane*DM+wid*8;
  const bf16*vsrc=Vh+(long)(16*(wid&3)+(lane>>2))*DM+(wid>>2)*32+(lane&3)*8;
  const unsigned kdst=lds0+LDS_K+wid*1024, vdst=lds0+LDS_V+wid*1024;
  #define KT(t) (((t)<4)?(4*c+(t)):(4*c+3-(t)))
  #define DMA_K(t,slot) glds16(ksrc+(long)KT(t)*KVBLK*DM,(unsigned)__builtin_amdgcn_readfirstlane(kdst+(slot)))
  #define DMA_V(t,slot) glds16(vsrc+(long)KT(t)*KVBLK*DM,(unsigned)__builtin_amdgcn_readfirstlane(vdst+(slot)))
  const int vb0=(int)(lds0+LDS_V)+((lane>>4)&1)*32+(lane&3)*8+(4*hi+((lane&15)>>2))*64;
  const char*Kbase=shm+LDS_K; bf16x8 kf[8];
  const lds_cptr shm3=(lds_cptr)shm; const lds_cptr kp0=shm3+LDS_K+hi*1024+r32*16; const lds_cptr vp0=shm3+LDS_V+((lane>>4)&1)*32+(lane&3)*8+(4*hi+((lane&15)>>2))*64;
  const int NT=4*c+4;
  #define NBV(t) (((t)<4||((selmask>>(KT(t)>>2))&1u))?__builtin_fmaf(slope2,(float)(64*KT(t)+4*hi-256*c-256),-mhat):-INFINITY)
  float sb0[16],sb1[16];
  #pragma unroll
  for(int r=0;r<16;++r){ const int k0=(r&3)+8*(r>>2); sb0[r]=sbias(k0,sexp); sb1[r]=sbias(k0+32,sexp); }
  #define BIAS(P0,P1,t) do{ const float nb_=NBV(t); _Pragma("unroll") for(int r=0;r<16;++r){P0[r]=(P0[r]+nb_)+sb0[r];P1[r]=(P1[r]+nb_)+sb1[r];} }while(0)
  DMA_K(0,0);DMA_V(0,0);DMA_K(1,SLOTB);
  bf16x8 qr[4];
  #pragma unroll
  for(int d0=0;d0<4;++d0)qr[d0]=*reinterpret_cast<const bf16x8*>(&Qw[(long)r32*DM+d0*16+hi*8]);
  float mhat=0.f,l_reg=0.f;o[0]=f32x16{};o[1]=f32x16{};const f32x16 negm=f32x16{};
  const int qrel=wid*QBLK+r32;
  #define CMASK(P0,P1,t) do{ if((t)<4)cmask(P0,P1,(t),qrel,hi); }while(0)
  bool resc=false;
  #define START(P0,P1) do{ const float rm=rowmax(P0,P1); resc=false; \
    { const float dl=rm; mhat=fadd_s(mhat,dl); \
      _Pragma("unroll") for(int r=0;r<16;++r){P0[r]=fsub_s(P0[r],dl);P1[r]=fsub_s(P1[r],dl);} } \
    _Pragma("unroll") for(int r=0;r<16;++r)P0[r]=__builtin_amdgcn_exp2f(P0[r]); }while(0)
  #define RESC() do{ if(resc){ asm volatile("s_waitcnt lgkmcnt(0)":::"memory"); \
      _Pragma("unroll") for(int d_=0;d_<2;++d_) _Pragma("unroll") for(int r=0;r<16;++r)o[d_][r]*=wsf[crow(r,hi)]; } }while(0)
  f32x16 pA0,pA1,pB0,pB1;
  int sl_prev=0,sl_cur=0,sl_next=SLOTB;
  #define ROT() do{sl_prev=sl_cur;sl_cur=sl_next;sl_next=(sl_next==(NSLOT-1)*SLOTB)?0:sl_next+SLOTB;}while(0)
  DMA_K(2,2*SLOTB);
  WAIT_BAR(3);
  qkt(pA0,pA1,Kbase,qr,negm,r32,hi);asm volatile("s_nop 15\n\ts_nop 7":"+v"(pA0),"+v"(pA1));BIAS(pA0,pA1,0);CMASK(pA0,pA1,0);
  START(pA0,pA1);
  _Pragma("unroll") for(int r=0;r<16;++r)pA1[r]=__builtin_amdgcn_exp2f(pA1[r]);
  WAIT_BAR(0);
  DMA_K(3,0);DMA_V(1,SLOTB);
  ROT();
  kload8(kf,kp0+sl_cur);
  WAIT_BAR(2);
  s16x4 vlo[8],vhi[8]; u32x4 pw0,pw1,pw2,pw3;
  #define PKW(P,B) cvtpk_s(P[B],P[B+1])
  #define PAF(k) __builtin_bit_cast(bf16x8,pw##k)
  #define VFR(i) (bf16x8){vlo[i][0],vlo[i][1],vlo[i][2],vlo[i][3],vhi[i][0],vhi[i][1],vhi[i][2],vhi[i][3]}
  #define PIN(x) asm volatile("":"+v"(x))
  #define MX3(a,b,c) __builtin_fmaxf(__builtin_fmaxf((a),(b)),(c))
  #define GAPA(MF,A0,A1,A2,A3,W0,W1,PW) do{ MF; sacc+=A0; sacc+=A1; sacc+=A2; sacc+=A3; PIN(sacc); W0; W1; PIN(PW); SBAR(); }while(0)
  #define EX(v) __builtin_amdgcn_exp2f(v)
  #define GAPB(MF,X,B) do{ MF; X[B]=EX(X[B]); X[B+1]=EX(X[B+1]); X[B+2]=EX(X[B+2]); X[B+3]=EX(X[B+3]); PIN(X); SBAR(); }while(0)
  #define VRD(i) do{ vlo[i]=vtr(vp_+(((i)>>2)*4096+((i)&3)*1024)); vhi[i]=vtr(vp_+(((i)>>2)*4096+((i)&3)*1024+512)); }while(0)
  #define KRD(G,j) do{ if(G){ kload2(kf,kp0+sl_next,j); SBAR(); } }while(0)
  #define STEP(C0,C1,P0,P1,t,GK,GV,GL) do{ SBAR(); \
    const lds_cptr vp_=vp0+sl_prev; \
    VRD(0); SBAR(); float sacc=(P0[0]+P0[1]); \
    GAPA(C0=__builtin_amdgcn_mfma_f32_32x32x16_bf16(kf[0],qr[0],negm,0,0,0), P0[2],P0[3],P0[4],P0[5],     pw0[0]=PKW(P0,0), pw0[1]=PKW(P0,2), pw0); \
    VRD(4); SBAR(); GAPA(C1=__builtin_amdgcn_mfma_f32_32x32x16_bf16(kf[1],qr[0],negm,0,0,0), P0[6],P0[7],P0[8],P0[9],     pw0[2]=PKW(P0,4), pw0[3]=PKW(P0,6), pw0); \
    VRD(1); SBAR(); GAPA(C0=__builtin_amdgcn_mfma_f32_32x32x16_bf16(kf[2],qr[1],C0,0,0,0),   P0[10],P0[11],P0[12],P0[13], pw1[0]=PKW(P0,8), pw1[1]=PKW(P0,10), pw1); \
    VRD(5); SBAR(); GAPA(C1=__builtin_amdgcn_mfma_f32_32x32x16_bf16(kf[3],qr[1],C1,0,0,0),   P0[14],P0[15],P1[0],P1[1],   pw1[2]=PKW(P0,12),pw1[3]=PKW(P0,14), pw1); \
    VRD(2); SBAR(); GAPA(C0=__builtin_amdgcn_mfma_f32_32x32x16_bf16(kf[4],qr[2],C0,0,0,0),   P1[2],P1[3],P1[4],P1[5],     pw2[0]=PKW(P1,0), pw2[1]=PKW(P1,2), pw2); \
    VRD(6); SBAR(); GAPA(C1=__builtin_amdgcn_mfma_f32_32x32x16_bf16(kf[5],qr[2],C1,0,0,0),   P1[6],P1[7],P1[8],P1[9],     pw2[2]=PKW(P1,4), pw2[3]=PKW(P1,6), pw2); \
    VRD(3); SBAR(); GAPA(C0=__builtin_amdgcn_mfma_f32_32x32x16_bf16(kf[6],qr[3],C0,0,0,0),   P1[10],P1[11],P1[12],P1[13], pw3[0]=PKW(P1,8), pw3[1]=PKW(P1,10), pw3); \
    VRD(7); SBAR(); GAPA(C1=__builtin_amdgcn_mfma_f32_32x32x16_bf16(kf[7],qr[3],C1,0,0,0),   P1[14],P1[15],0.f,0.f,       pw3[2]=PKW(P1,12),pw3[3]=PKW(P1,14), pw3); \
    l_reg+=sacc; \
    if(GK){DMA_K((t)+3,sl_cur);} if(GV){DMA_V((t)+1,sl_next);} \
    BIAS(C0,C1,t); CMASK(C0,C1,t); \
    { float a=MX3(C0[0],C0[1],C1[0]),b=MX3(C0[2],C0[3],C1[1]); a=MX3(a,C1[2],C1[3]); \
      _Pragma("unroll") for(int r=4;r<16;r+=4){a=MX3(a,C0[r],C0[r+1]);b=MX3(b,C0[r+2],C0[r+3]);a=MX3(a,C1[r],C1[r+1]);b=MX3(b,C1[r+2],C1[r+3]);} \
      float rm=__builtin_fmaxf(a,b); { auto rr=__builtin_amdgcn_permlane32_swap(__float_as_uint(rm),__float_as_uint(rm),false,false); rm=__builtin_fmaxf(__uint_as_float(rr[0]),__uint_as_float(rr[1])); } \
      resc=false; \
      if(__builtin_expect(__any(rm>(float)THRL),0)){ const float dl=__builtin_fmaxf(rm,0.f); mhat+=dl; \
        _Pragma("unroll") for(int r=0;r<16;++r){C0[r]-=dl;C1[r]-=dl;} \
        const float f=__builtin_amdgcn_exp2f(-dl); l_reg*=f; if(hi==0)wsf[r32]=f; resc=true; } } \
    SBAR(); \
    GAPB(o[0]=__builtin_amdgcn_mfma_f32_32x32x16_bf16(PAF(0),VFR(0),o[0],0,0,0), C0,0); \
    GAPB(o[1]=__builtin_amdgcn_mfma_f32_32x32x16_bf16(PAF(0),VFR(4),o[1],0,0,0), C0,4); \
    KRD(GL,0); GAPB(o[0]=__builtin_amdgcn_mfma_f32_32x32x16_bf16(PAF(1),VFR(1),o[0],0,0,0), C0,8); \
    KRD(GL,1); GAPB(o[1]=__builtin_amdgcn_mfma_f32_32x32x16_bf16(PAF(1),VFR(5),o[1],0,0,0), C0,12); \
    KRD(GL,2); GAPB(o[0]=__builtin_amdgcn_mfma_f32_32x32x16_bf16(PAF(2),VFR(2),o[0],0,0,0), C1,0); \
    KRD(GL,3); GAPB(o[1]=__builtin_amdgcn_mfma_f32_32x32x16_bf16(PAF(2),VFR(6),o[1],0,0,0), C1,4); \
    GAPB(o[0]=__builtin_amdgcn_mfma_f32_32x32x16_bf16(PAF(3),VFR(3),o[0],0,0,0), C1,8); \
    GAPB(o[1]=__builtin_amdgcn_mfma_f32_32x32x16_bf16(PAF(3),VFR(7),o[1],0,0,0), C1,12); \
    }while(0)
  int t=1;
  #define ENDW(tt) do{ if((tt)+3<NT){WAIT_BAR(2);} else if((tt)+2<NT){WAIT_BAR(1);} else {WAIT_BAR(0);} }while(0)
  for(;t+1<NT&&t<5;t+=2){
    STEP(pB0,pB1,pA0,pA1,t,(t+3<NT),(t+1<NT),(t+1<NT));       ENDW(t);   RESC(); ROT();
    STEP(pA0,pA1,pB0,pB1,t+1,(t+4<NT),(t+2<NT),(t+2<NT));     ENDW(t+1); RESC(); ROT();
  }
  #undef CMASK
  #define CMASK(P0,P1,t) do{}while(0)
  for(;t+5<NT;t+=2){
    STEP(pB0,pB1,pA0,pA1,t,true,true,true);     WAIT_BAR(2); RESC(); ROT();
    STEP(pA0,pA1,pB0,pB1,t+1,true,true,true);   WAIT_BAR(2); RESC(); ROT();
  }
  #undef CMASK
  #define CMASK(P0,P1,t) do{ if((t)<4)cmask(P0,P1,(t),qrel,hi); }while(0)
  for(;t+1<NT;t+=2){
    STEP(pB0,pB1,pA0,pA1,t,(t+3<NT),(t+1<NT),(t+1<NT));       ENDW(t);   RESC(); ROT();
    STEP(pA0,pA1,pB0,pB1,t+1,(t+4<NT),(t+2<NT),(t+2<NT));     ENDW(t+1); RESC(); ROT();
  }
  STEP(pB0,pB1,pA0,pA1,NT-1,false,false,false); RESC();
  { float sacc=pB0[0]+pB0[1]; _Pragma("unroll") for(int r=2;r<16;++r)sacc+=pB0[r]; _Pragma("unroll") for(int r=0;r<16;++r)sacc+=pB1[r]; l_reg+=sacc;
    pw0=(u32x4){PKW(pB0,0),PKW(pB0,2),PKW(pB0,4),PKW(pB0,6)};pw1=(u32x4){PKW(pB0,8),PKW(pB0,10),PKW(pB0,12),PKW(pB0,14)};pw2=(u32x4){PKW(pB1,0),PKW(pB1,2),PKW(pB1,4),PKW(pB1,6)};pw3=(u32x4){PKW(pB1,8),PKW(pB1,10),PKW(pB1,12),PKW(pB1,14)};
    SBAR(); pv(o,vb0+sl_cur,PAF(0),PAF(1),PAF(2),PAF(3)); }
  #undef PKW
  #undef PAF
  #undef VFR
  #undef PIN
  #undef MX3
  #undef GAPA
  #undef GAPB
  #undef EX
  #undef VRD
  #undef KRD
  #undef STEP
  #undef ENDW
  {auto rr=__builtin_amdgcn_permlane32_swap(__float_as_uint(l_reg),__float_as_uint(l_reg),false,false);l_out=__uint_as_float(rr[0])+__uint_as_float(rr[1]);}
  #undef KT
  #undef NBV
  #undef BIAS
  #undef DMA_K
  #undef DMA_V
  #undef CMASK
  #undef START
  #undef RESC
  #undef ROT
}
__device__ __forceinline__ unsigned moba_select(int c,const bf16*Qw,const float*ksum,int r32,int hi){
  if(c<=3)return (1u<<c)-1u;
  f32x16 acc=f32x16{};
  #pragma unroll
  for(int d0=0;d0<4;++d0){
    const bf16x8 q=*reinterpret_cast<const bf16x8*>(&Qw[(long)r32*DM+d0*16+hi*8]);
    const float*kp=ksum+(r32&15)*64+d0*16+hi*8; const f32x4_t a=*(const f32x4_t*)kp, b=*(const f32x4_t*)(kp+4);
    u32x4 wh,wl;
    wh[0]=cvtpk_s(a[0],a[1]); wh[1]=cvtpk_s(a[2],a[3]); wh[2]=cvtpk_s(b[0],b[1]); wh[3]=cvtpk_s(b[2],b[3]);
    wl[0]=cvtpk_s(a[0]-__uint_as_float(wh[0]<<16),a[1]-__uint_as_float(wh[0]&0xffff0000u)); wl[1]=cvtpk_s(a[2]-__uint_as_float(wh[1]<<16),a[3]-__uint_as_float(wh[1]&0xffff0000u));
    wl[2]=cvtpk_s(b[0]-__uint_as_float(wh[2]<<16),b[1]-__uint_as_float(wh[2]&0xffff0000u)); wl[3]=cvtpk_s(b[2]-__uint_as_float(wh[3]<<16),b[3]-__uint_as_float(wh[3]&0xffff0000u));
    acc=__builtin_amdgcn_mfma_f32_32x32x16_bf16(__builtin_bit_cast(bf16x8,wh),q,acc,0,0,0);
    acc=__builtin_amdgcn_mfma_f32_32x32x16_bf16(__builtin_bit_cast(bf16x8,wl),q,acc,0,0,0);
  }
  float g[16];
  #pragma unroll
  for(int r=0;r<8;++r){ auto rr=__builtin_amdgcn_permlane32_swap(__float_as_uint(acc[r]),__float_as_uint(acc[r]),false,false);
    g[(r&3)+8*(r>>2)]=__uint_as_float(rr[0]); g[(r&3)+8*(r>>2)+4]=__uint_as_float(rr[1]); }
  float v0=-INFINITY,v1=-INFINITY,v2=-INFINITY; int i0=0,i1=0,i2=0;
  #pragma unroll
  for(int j=0;j<15;++j){ const float s=(j<c)?g[j]:-INFINITY;
    const bool a0=s>v0, a1=s>v1, a2=s>v2;
    v2=a1?v1:(a2?s:v2); i2=a1?i1:(a2?j:i2);
    v1=a0?v0:(a1?s:v1); i1=a0?i0:(a1?j:i1);
    v0=a0?s:v0;         i0=a0?j:i0; }
  return (1u<<i0)|(1u<<i1)|(1u<<i2);
}
template<int THRL> __device__ __forceinline__ void attn_unit(int kind,int stream,int c,const bf16*proj,const float*ksum,bf16*mix,float*Dbuf,float lam,char*shm){
  int tid0=threadIdx.x; asm volatile("":"+v"(tid0));
  const int b=stream>>3;
  const long rowb=(long)b*SEQ;
  int qcol,kcol,vcol,ocol,sexp; unsigned sm=0xffffffffu;
  if(kind==0){ const int h=stream&7; qcol=h*64; kcol=512+h*64; vcol=1024+h*64; ocol=h*64; sexp=h+1;
    sm=moba_select(c,proj+(rowb+c*QB+(tid0>>6)*QBLK)*DM+qcol,ksum+(long)stream*16*64,tid0&31,(tid0>>5)&1); }
  else { const int hd=(stream>>1)&3, vh=stream&1; qcol=1536+hd*128; kcol=2048+hd*128; vcol=2560+hd*128+vh*64; ocol=hd*128+vh*64; sexp=2*(hd+1); }
  #pragma unroll 1
  for(int mp=0;mp<=kind;++mp){
    f32x16 o[2]; float l;
    attn_core<THRL>(c,proj+(rowb+c*QB+(tid0>>6)*QBLK)*DM+qcol+mp*64,proj+rowb*DM+kcol+mp*64,proj+rowb*DM+vcol,sm,sexp,shm,o,l);
    int tid2=threadIdx.x; asm volatile("":"+v"(tid2)); const int lane=tid2&63,r32=lane&31,hi=lane>>5; const int wid=__builtin_amdgcn_readfirstlane(tid2>>6);
    const long row0=rowb+c*QB+wid*QBLK;
    float*wsf=(float*)(shm+LDS_WS)+wid*64;
    float*stash=(float*)(shm+LDS_STASH)+wid*2048;
    if(hi==0)wsf[32+r32]=l; asm volatile("s_waitcnt lgkmcnt(0)":::"memory");
    float rli[16];
    #pragma unroll
    for(int r=0;r<16;++r)rli[r]=__builtin_amdgcn_rcpf(wsf[32+crow(r,hi)]);
    if(kind==0){
      bf16*Ow=mix+row0*1024+ocol; bf16*stg=(bf16*)(shm+LDS_OST)+wid*2048;
      #pragma unroll
      for(int r=0;r<16;r+=1){const int orow=crow(r,hi);
        #pragma unroll
        for(int d0=0;d0<2;++d0)stg[orow*64+d0*32+r32]=(bf16)(cvtpk_s(o[d0][r]*rli[r],0.f)&0xffffu);}
      asm volatile("s_waitcnt lgkmcnt(0)":::"memory");
      #pragma unroll
      for(int i=0;i<4;++i){const int row=i*8+(lane>>3),ch=lane&7; const u32x4 v=*(const u32x4*)(stg+row*64+ch*8); ATTN_STORE16(Ow+(long)row*1024+ch*8,v);}
    } else if(mp==0){
      #pragma unroll
      for(int d0=0;d0<2;++d0)
        #pragma unroll
        for(int r=0;r<16;++r)stash[(d0*16+r)*64+lane]=o[d0][r]*rli[r];
    } else {
      #pragma unroll
      for(int d0=0;d0<2;++d0)
        #pragma unroll
        for(int r=0;r<16;++r)o[d0][r]=stash[(d0*16+r)*64+lane]-lam*(o[d0][r]*rli[r]);
      asm volatile("s_waitcnt lgkmcnt(0)":::"memory");
      #pragma unroll
      for(int r=0;r<16;++r){const int orow=crow(r,hi);
        #pragma unroll
        for(int d0=0;d0<2;++d0)stash[orow*64+d0*32+r32]=o[d0][r];}
      asm volatile("s_waitcnt lgkmcnt(0)":::"memory");
      float*Dw=Dbuf+row0*512+ocol;
      #pragma unroll
      for(int i=0;i<8;++i){const int row=i*4+(lane>>4),ch=lane&15; const f32x4_t v=*(const f32x4_t*)(stash+row*64+ch*4); *(f32x4_t*)(Dw+(long)row*512+ch*4)=v;}
    }
    asm volatile("s_waitcnt lgkmcnt(0)\n\ts_barrier":::"memory");
  }
}
constexpr int ATTN_LDS_BYTES=LDS_BYTES;
template<int THRL=8> __device__ __forceinline__ void attn_phase(char*lds,const bf16*proj,const float*ksum,bf16*mix,float*Dbuf,float lam,int vcu){
  const int stream=vcu>>2, s=vcu&3;
  #pragma unroll 1
  for(int u=0;u<8;++u){ const int i=u&3, c=(i==0)?s:(i==1)?15-s:(i==2)?4+s:11-s;
    attn_unit<THRL>(u<4?1:0,stream,c,proj,ksum,mix,Dbuf,lam,lds); }
}
#undef SBAR
#undef WAIT_BAR
}
#define GAS __attribute__((address_space(1)))
#define LAS __attribute__((address_space(3)))
typedef unsigned short bf16;
typedef unsigned v4u __attribute__((ext_vector_type(4)));
typedef float f32x4 __attribute__((ext_vector_type(4)));
typedef short bf16x8 __attribute__((ext_vector_type(8)));
typedef GAS unsigned gu32;
typedef GAS unsigned long long gu64;
#define RLX_AGENT __ATOMIC_RELAXED, __HIP_MEMORY_SCOPE_AGENT
#define LDS_WAIT() asm volatile("s_waitcnt lgkmcnt(0)" ::: "memory")
#define VM_WAIT() asm volatile("s_waitcnt vmcnt(0)" ::: "memory")
__device__ __forceinline__ unsigned long long rt() { return __builtin_amdgcn_s_memrealtime(); }
__device__ __forceinline__ unsigned f2bf(float f) { unsigned u = __builtin_bit_cast(unsigned, f); return (u + 0x7fffu + ((u >> 16) & 1u)) >> 16; }
__device__ __forceinline__ unsigned pk2(float lo, float hi) { return f2bf(lo) | (f2bf(hi) << 16); }

#define XB_TMO      128
#define XB_XCNT(j)  (256  + 64 * (j))
#define XB_XSUB(j)  (1280 + 64 * (j))
#define XB_XGEN(j)  (2304 + 64 * (j))
#define XB_TOP      3328
#define XB_TOPGEN   3392
#define XCD_BAR_WORDS 3456
#define XB_SPIN_CAP (1u << 22)

__device__ __forceinline__ unsigned xb_ld(unsigned* p)              { return __hip_atomic_load(p, __ATOMIC_RELAXED, __HIP_MEMORY_SCOPE_AGENT); }
__device__ __forceinline__ unsigned xb_add(unsigned* p, unsigned v) { return __hip_atomic_fetch_add(p, v, __ATOMIC_RELAXED, __HIP_MEMORY_SCOPE_AGENT); }
__device__ __forceinline__ unsigned xb_xcc_id() { return (unsigned)__builtin_amdgcn_s_getreg((3 << 11) | 20) & 0xFu; }
#define XB_SPIN(cond, bar) do { unsigned _sp = 0; while (cond) { __builtin_amdgcn_s_sleep(1); \
    if ((++_sp & 255u) == 0u) { if (xb_ld(&(bar)[XB_TMO])) break; if (_sp > XB_SPIN_CAP) { atomicAdd(&(bar)[XB_TMO], 1u); break; } } } } while (0)

struct XcdBarrier {
    unsigned* bar; unsigned x;
    volatile LAS unsigned* st;
};

__device__ __forceinline__ XcdBarrier xcd_barrier_post(unsigned* bar, volatile LAS unsigned* st) {
    XcdBarrier b; b.bar = bar; b.x = xb_xcc_id(); b.st = st;
    if (threadIdx.x == 0) (void)xb_add(&bar[XB_XCNT(b.x)], 1u);
    return b;
}
__device__ __forceinline__ void xcd_barrier_complete(unsigned* bar, unsigned x, unsigned& nloc, unsigned& nx) {
    const unsigned G = gridDim.x * gridDim.y * gridDim.z;
    unsigned sum, cnt, mine, sp = 0u;
    for (;;) {
        sum = 0u; cnt = 0u; mine = 0u;
#pragma unroll
        for (unsigned j = 0; j < 16; ++j) { const unsigned c = xb_ld(&bar[XB_XCNT(j)]); sum += c; cnt += (c > 0u) ? 1u : 0u; mine = (j == x) ? c : mine; }
        if (sum == G) break;
        __builtin_amdgcn_s_sleep(1);
        if ((++sp & 255u) == 0u) { if (xb_ld(&bar[XB_TMO])) break; if (sp > XB_SPIN_CAP) { atomicAdd(&bar[XB_TMO], 1u); break; } }
    }
    nloc = mine > 0u ? mine : 1u; nx = cnt > 0u ? cnt : 1u;
}

__device__ __forceinline__ void xcd_barrier(const XcdBarrier& b) {
    asm volatile("s_waitcnt vmcnt(0)" ::: "memory");
    __syncthreads();
    if (threadIdx.x == 0) {
        unsigned* bar = b.bar;
        __builtin_amdgcn_s_waitcnt(0);
        unsigned nloc = b.st[0], nx = b.st[1];
        if (nloc == 0u) { xcd_barrier_complete(bar, b.x, nloc, nx); b.st[0] = nloc; b.st[1] = nx; }
        const unsigned old = xb_add(&bar[XB_XSUB(b.x)], 1u);
        const unsigned gen = old / nloc;
        if (old + 1u == (gen + 1u) * nloc) {
            __builtin_amdgcn_fence(__ATOMIC_RELEASE, "agent");
            asm volatile("s_waitcnt vmcnt(0)" ::: "memory");
            const unsigned og = xb_add(&bar[XB_TOP], 1u);
            const unsigned tg = og / nx;
            if (og + 1u == (tg + 1u) * nx) xb_add(&bar[XB_TOPGEN], 1u);
            else XB_SPIN(xb_ld(&bar[XB_TOPGEN]) == tg, bar);
            __builtin_amdgcn_fence(__ATOMIC_ACQUIRE, "agent");
            xb_add(&bar[XB_XGEN(b.x)], 1u);
            asm volatile("s_waitcnt vmcnt(0)" ::: "memory");
        } else {
            XB_SPIN(xb_ld(&bar[XB_XGEN(b.x)]) == gen, bar);
            __builtin_amdgcn_fence(__ATOMIC_ACQUIRE, "agent");
            asm volatile("s_waitcnt vmcnt(0)" ::: "memory");
        }
    }
    __syncthreads();
}

constexpr int BATCH = 8, SEQ = 4096, DM = 1024, DEPTH = 2, FF = 2816, NGU = 2 * FF, INW = 3072;
constexpr int M = BATCH * SEQ;
constexpr int NHM = 8, NHD = 4;
constexpr int MIXW = 1024, DW = 512;
constexpr float RMS_EPS = 1e-6f;
constexpr float LOG2E = 1.4426950408889634f;
constexpr float C2 = 0.125f * LOG2E;
constexpr int PC_QM = 0, PC_KM = 512, PC_VM = 1024, PC_QD = 1536, PC_KD = 2048, PC_VD = 2560;
enum PhaseKind { K_GU1 = 0, K_DN1, K_EW1, K_WIN, K_ATTN, K_DNORM, K_WOUT, K_EW2, K_GU2, K_DN2, K_EW3, PH_PER_LAYER };
constexpr int NPHASE = 1 + DEPTH * PH_PER_LAYER;

constexpr size_t MiB = 1u << 20;
constexpr size_t WS_CTL = 0, CTL_ZERO_BYTES = 1 * MiB;
constexpr size_t WS_KSUM = 256 * 1024, KSUM_BYTES = 256 * 1024;
constexpr size_t WS_W = 4 * MiB, W_LAYER = 41 * MiB;
constexpr size_t W_GU1 = 0, W_DN1 = 11 * MiB, W_IN = W_DN1 + 11 * MiB / 2, W_OUT = W_IN + 6 * MiB, W_GU2 = W_OUT + 2 * MiB, W_DN2 = W_GU2 + 11 * MiB;
static_assert(W_DN2 + 11 * MiB / 2 == W_LAYER, "weight map");
constexpr size_t WS_H = 88 * MiB;
constexpr size_t WS_Y = 152 * MiB;
constexpr size_t WS_BIG = 280 * MiB;
constexpr size_t WS_END = 472 * MiB;
static_assert(WS_KSUM + DEPTH * KSUM_BYTES <= CTL_ZERO_BYTES && WS_W + DEPTH * W_LAYER <= WS_H && WS_H + (size_t)M * DM * 2 <= WS_Y && WS_Y + (size_t)M * DM * 4 <= WS_BIG && WS_BIG + (size_t)M * INW * 2 <= WS_END, "d_ws map");
constexpr int CW_TMO = 0, CW_CODE = 1, CW_BAR = 4096;

constexpr int RING_OFF = 0, SCRATCH_BYTES = 153600;
constexpr int LDSCTL_OFF = SCRATCH_BYTES, MISC_OFF = LDSCTL_OFF + 320;
constexpr int LDS_BYTES = 155648;
static_assert(MISC_OFF + 128 <= LDS_BYTES && attn_body::ATTN_LDS_BYTES <= SCRATCH_BYTES, "LDS map");
constexpr int NWAVES = 8;

__device__ __forceinline__ float bf2f(unsigned u) { return __uint_as_float(u << 16); }
__device__ __forceinline__ float wave_sum(float v) {
#pragma unroll
    for (int o = 1; o < 64; o <<= 1) v += __shfl_xor(v, o);
    return v;
}
__device__ __forceinline__ float dot4(f32x4 a, f32x4 b) { return (a.x * b.x + a.y * b.y) + (a.z * b.z + a.w * b.w); }

__device__ __forceinline__ void transpose_item(const float* W, int K, int N, bf16* WT, int kb, int nb, int dstrow0, LAS float* scr, int lane) {
    const int k0 = 64 * kb, n0 = 32 * nb;
#pragma unroll 8
    for (int i = 0; i < 32; ++i) { const int kk = 2 * i + (lane >> 5); scr[kk * 33 + (lane & 31)] = W[(size_t)(k0 + kk) * N + n0 + (lane & 31)]; }
    LDS_WAIT(); asm volatile("" ::: "memory");
    const int c = lane & 7;
#pragma unroll
    for (int j = 0; j < 4; ++j) { const int n = (lane >> 3) + 8 * j; const LAS float* s = scr + (8 * c) * 33 + n;
        v4u o; o.x = pk2(s[0 * 33], s[1 * 33]); o.y = pk2(s[2 * 33], s[3 * 33]); o.z = pk2(s[4 * 33], s[5 * 33]); o.w = pk2(s[6 * 33], s[7 * 33]);
        *(GAS v4u*)(WT + (size_t)(dstrow0 + n0 + n) * K + k0 + 8 * c) = o; }
    LDS_WAIT(); asm volatile("" ::: "memory");
}
__device__ __forceinline__ void rms_row_to_bf16(const float* xrow, const float* g, bf16* orow, int lane) {
    const GAS f32x4* xr = (const GAS f32x4*)xrow + lane; const GAS f32x4* gr = (const GAS f32x4*)g + lane;
    f32x4 v[4]; float s = 0.f;
#pragma unroll
    for (int j = 0; j < 4; ++j) { v[j] = xr[64 * j]; s += dot4(v[j], v[j]); }
    const float r = 1.f / sqrtf(wave_sum(s) * (1.f / DM) + RMS_EPS);
    GAS unsigned long long* o8 = (GAS unsigned long long*)orow + lane;
#pragma unroll
    for (int j = 0; j < 4; ++j) { const f32x4 gg = gr[64 * j]; const f32x4 h = v[j] * gg * r;
        o8[64 * j] = (unsigned long long)pk2(h.x, h.y) | ((unsigned long long)pk2(h.z, h.w) << 32); }
}
struct Args { const float* in[20]; float* out; unsigned char* ws; int ph_lo, ph_hi, li, pad; };
constexpr int ITEMS_FFW = 16 * 88, ITEMS_DNW = 44 * 32, ITEMS_INW = 16 * 96, ITEMS_OUTW = 16 * 32;
constexpr int ITEMS_LAYER = 4 * ITEMS_FFW + 2 * ITEMS_DNW + ITEMS_INW + ITEMS_OUTW;
typedef const __attribute__((address_space(4))) Args* kargs_t0;
__device__ __forceinline__ void prologue_phase(kargs_t0 Pq, LAS unsigned char* lds, int gw, int NGW, int wave, int lane) {
    LAS float* scr = (LAS float*)(lds + RING_OFF + wave * 16384);
    for (int it = gw; it < DEPTH * ITEMS_LAYER; it += NGW) {
        const int l = it / ITEMS_LAYER; int r = it % ITEMS_LAYER;
        unsigned char* wl = Pq->ws + WS_W + (size_t)l * W_LAYER;
        const size_t offF = (size_t)l * DM * FF, offI = (size_t)l * DM * INW, offO = (size_t)l * DM * DM;
        if (r < 2 * ITEMS_FFW) { const int up = r >= ITEMS_FFW; if (up) r -= ITEMS_FFW; const int kb = r / 88, nb = r % 88, n0 = 32 * nb;
            transpose_item((up ? Pq->in[3] : Pq->in[2]) + offF, DM, FF, (bf16*)(wl + W_GU1), kb, nb, 256 * (n0 >> 7) + (n0 & 127) + up * 128 - n0, scr, lane); continue; }
        r -= 2 * ITEMS_FFW;
        if (r < ITEMS_DNW) { transpose_item(Pq->in[4] + offF, FF, DM, (bf16*)(wl + W_DN1), r / 32, r % 32, 0, scr, lane); continue; }
        r -= ITEMS_DNW;
        if (r < ITEMS_INW) { transpose_item(Pq->in[7] + offI, DM, INW, (bf16*)(wl + W_IN), r / 96, r % 96, 0, scr, lane); continue; }
        r -= ITEMS_INW;
        if (r < ITEMS_OUTW) { transpose_item(Pq->in[13] + offO, DM, DM, (bf16*)(wl + W_OUT), r / 32, r % 32, 0, scr, lane); continue; }
        r -= ITEMS_OUTW;
        if (r < 2 * ITEMS_FFW) { const int up = r >= ITEMS_FFW; if (up) r -= ITEMS_FFW; const int kb = r / 88, nb = r % 88, n0 = 32 * nb;
            transpose_item((up ? Pq->in[17] : Pq->in[16]) + offF, DM, FF, (bf16*)(wl + W_GU2), kb, nb, 256 * (n0 >> 7) + (n0 & 127) + up * 128 - n0, scr, lane); continue; }
        r -= 2 * ITEMS_FFW;
        transpose_item(Pq->in[18] + offF, FF, DM, (bf16*)(wl + W_DN2), r / 32, r % 32, 0, scr, lane);
    }
    bf16* H = (bf16*)(Pq->ws + WS_H);
    for (int m = gw; m < M; m += NGW) rms_row_to_bf16(Pq->in[0] + (size_t)m * DM, Pq->in[1], H + (size_t)m * DM, lane);
}
__device__ __forceinline__ void ew_phase(const float* xsrc, const float* Y, float* xdst, float coef, const float* gpost, const float* gnext, bf16* H, int gw, int NGW, int lane) {
    for (int r = gw; r < M; r += NGW) {
        const GAS f32x4* xr = (const GAS f32x4*)(xsrc + (size_t)r * DM) + lane; const GAS f32x4* yr = (const GAS f32x4*)(Y + (size_t)r * DM) + lane;
        const GAS f32x4* g1 = (const GAS f32x4*)gpost + lane;
        f32x4 xv[4], yv[4]; float s = 0.f;
#pragma unroll
        for (int j = 0; j < 4; ++j) { yv[j] = yr[64 * j]; xv[j] = xr[64 * j]; s += dot4(yv[j], yv[j]); }
        const float r1 = coef / sqrtf(wave_sum(s) * (1.f / DM) + RMS_EPS);
        float s2 = 0.f; GAS f32x4* xo = (GAS f32x4*)(xdst + (size_t)r * DM) + lane;
#pragma unroll
        for (int j = 0; j < 4; ++j) { xv[j] = xv[j] + yv[j] * g1[64 * j] * r1; s2 += dot4(xv[j], xv[j]); xo[64 * j] = xv[j]; }
        if (gnext) {
            const float r2 = 1.f / sqrtf(wave_sum(s2) * (1.f / DM) + RMS_EPS);
            const GAS f32x4* g2 = (const GAS f32x4*)gnext + lane; GAS unsigned long long* o8 = (GAS unsigned long long*)(H + (size_t)r * DM) + lane;
#pragma unroll
            for (int j = 0; j < 4; ++j) { const f32x4 h = xv[j] * g2[64 * j] * r2; o8[64 * j] = (unsigned long long)pk2(h.x, h.y) | ((unsigned long long)pk2(h.z, h.w) << 32); }
        }
    }
}
__device__ __forceinline__ void diffnorm_phase(const float* Dbuf, const float* subg, float osc, bf16* mix, int gw, int NGW, int lane) {
    for (int r = gw; r < M; r += NGW) {
        const GAS f32x4* dr = (const GAS f32x4*)(Dbuf + (size_t)r * DW) + lane;
        const f32x4 a = dr[0], b = dr[64];
        float sa = dot4(a, a), sb = dot4(b, b);
#pragma unroll
        for (int o = 1; o < 32; o <<= 1) { sa += __shfl_xor(sa, o); sb += __shfl_xor(sb, o); }
        const float ra = osc / sqrtf(sa * (1.f / 128.f) + RMS_EPS), rb = osc / sqrtf(sb * (1.f / 128.f) + RMS_EPS);
        const f32x4 g = ((const GAS f32x4*)subg)[lane & 31];
        const f32x4 oa = a * g * ra, ob = b * g * rb;
        GAS unsigned long long* o8 = (GAS unsigned long long*)(mix + (size_t)r * MIXW + DW) + lane;
        o8[0] = (unsigned long long)pk2(oa.x, oa.y) | ((unsigned long long)pk2(oa.z, oa.w) << 32);
        o8[64] = (unsigned long long)pk2(ob.x, ob.y) | ((unsigned long long)pk2(ob.z, ob.w) << 32);
    }
}
__device__ __forceinline__ float lam_init_of(int l) { return l == 0 ? 0.2f : 0.35550907f; }

typedef const __attribute__((address_space(4))) Args* kargs_t;
__global__ void __launch_bounds__(NWAVES * 64, 2) mk_fwd(Args args_unused) {
    extern __shared__ __attribute__((aligned(16))) unsigned char lds[];
    LAS unsigned char* L = (LAS unsigned char*)lds;
    volatile LAS unsigned* MISC = (volatile LAS unsigned*)(L + MISC_OFF);
    for (int u = threadIdx.x; u < (LDS_BYTES - LDSCTL_OFF) / 4; u += NWAVES * 64) ((LAS unsigned*)(L + LDSCTL_OFF))[u] = 0u;
    __syncthreads();
    kargs_t ap0 = (kargs_t)__builtin_amdgcn_kernarg_segment_ptr();
    const int lo = ap0->ph_lo, hi = ap0->ph_hi;
    XcdBarrier bar; bar.bar = (unsigned*)((gu32*)(ap0->ws + WS_CTL) + CW_BAR) + ap0->li * XCD_BAR_WORDS; bar.x = 0; bar.st = MISC + 8;
    if (hi - lo > 1) bar = xcd_barrier_post(bar.bar, MISC + 8);

    for (int ph = lo; ph < hi; ++ph) {
        if (ph > lo) xcd_barrier(bar);
        kargs_t P = (kargs_t)__builtin_amdgcn_kernarg_segment_ptr(); asm volatile("" : "+s"(P));
        int tid = threadIdx.x; asm volatile("" : "+v"(tid));
        const int lane = tid & 63, wave = __builtin_amdgcn_readfirstlane(tid >> 6);
        int G = gridDim.x, bx = blockIdx.x; asm volatile("" : "+s"(G), "+s"(bx));
        const int vcu = (G % 8 == 0) ? (bx % 8) * (G / 8) + bx / 8 : bx;
        const int gw = vcu * NWAVES + wave, NGW = G * NWAVES;
        unsigned char* ws = P->ws;
        bf16* H = (bf16*)(ws + WS_H); float* Y = (float*)(ws + WS_Y); float* Dbuf = (float*)(ws + WS_Y);
        bf16* BIG = (bf16*)(ws + WS_BIG);
        if (ph == 0) { prologue_phase(P, L, gw, NGW, wave, lane); continue; }
        const int l = (ph - 1) / PH_PER_LAYER, k = (ph - 1) % PH_PER_LAYER;
        unsigned char* wl = ws + WS_W + (size_t)l * W_LAYER;
        float* ksum = (float*)(ws + WS_KSUM + (size_t)l * KSUM_BYTES);
        if (k == K_GU1 || k == K_GU2) {
            pg8::Gemm g{H, (const bf16*)(wl + (k == K_GU1 ? W_GU1 : W_GU2)), M, NGU, DM}; pg8::StaticOrder S; S.init(M, NGU, G, bx);
            pg8::EpiSwiGLU E{BIG, FF};
            pg8::gemm_phase<pg8::EpiSwiGLU, pg8::StaticOrder, true, true>(L + RING_OFF, g, S, E);
        } else if (k == K_DN1 || k == K_DN2) {
            pg8::Gemm g{BIG, (const bf16*)(wl + (k == K_DN1 ? W_DN1 : W_DN2)), M, DM, FF}; pg8::StaticOrder S; S.init(M, DM, G, bx);
            pg8::EpiF32 E{Y, DM};
            pg8::gemm_phase<pg8::EpiF32, pg8::StaticOrder, true, true>(L + RING_OFF, g, S, E);
        } else if (k == K_WOUT) {
            pg8::Gemm g{H, (const bf16*)(wl + W_OUT), M, DM, DM}; pg8::StaticOrder S; S.init(M, DM, G, bx);
            pg8::EpiF32 E{Y, DM};
            pg8::gemm_phase<pg8::EpiF32, pg8::StaticOrder, true, true>(L + RING_OFF, g, S, E);
        } else if (k == K_WIN) {
            pg8::Gemm g{H, (const bf16*)(wl + W_IN), M, INW, DM}; pg8::StaticOrder S; S.init(M, INW, G, bx);
            pg8::EpiProj E{BIG, INW, 0xC3u, C2, ksum};
            pg8::gemm_phase<pg8::EpiProj, pg8::StaticOrder, true, true>(L + RING_OFF, g, S, E);
        } else if (k == K_EW1 || k == K_EW2 || k == K_EW3) {
            const float* xsrc = (l == 0 && k == K_EW1) ? P->in[0] : P->out;
            const float coef = (k == K_EW2) ? 1.0f : 0.5f;
            const float* gpost = (k == K_EW1 ? P->in[5] : k == K_EW2 ? P->in[14] : P->in[19]) + (size_t)l * DM;
            const float* gnext = (k == K_EW1) ? P->in[6] + (size_t)l * DM : (k == K_EW2) ? P->in[15] + (size_t)l * DM : (l + 1 < DEPTH ? P->in[1] + (size_t)(l + 1) * DM : nullptr);
            ew_phase(xsrc, Y, P->out, coef, gpost, gnext, H, gw, NGW, lane);
        } else if (k == K_ATTN) {
            float s1 = 0.f, s2 = 0.f;
            for (int i = 0; i < 64; ++i) { s1 += P->in[8][l * 64 + i] * P->in[9][l * 64 + i]; s2 += P->in[10][l * 64 + i] * P->in[11][l * 64 + i]; }
            const float lam = expf(s1) - expf(s2) + lam_init_of(l);
            if (G == 256) attn_body::attn_phase<8>((char*)lds + RING_OFF, (const attn_body::bf16*)BIG, ksum, (attn_body::bf16*)H, Dbuf, lam, vcu);
        } else if (k == K_DNORM) {
            diffnorm_phase(Dbuf, P->in[12] + (size_t)l * 128, 1.0f - lam_init_of(l), H, gw, NGW, lane);
        }
    }
}

extern "C" void kernel_launch(void* const* d_in, const int* in_sizes, int n_in, void* d_out, int out_size, void* d_ws, size_t ws_size, hipStream_t stream) {
    static int grid = 0;
    if (grid == 0) {
        if (n_in != 20 || in_sizes[0] != M * DM || out_size != M * DM || ws_size < WS_END) { fprintf(stderr, "kernel_launch: unexpected shapes (n_in %d, in0 %d, out %d, ws %zu); nothing launched\n", n_in, n_in > 0 ? in_sizes[0] : -1, out_size, ws_size); grid = -1; return; }
        int dev = 0, cus = 0;
        if (hipGetDevice(&dev) != hipSuccess || hipDeviceGetAttribute(&cus, hipDeviceAttributeMultiprocessorCount, dev) != hipSuccess) { grid = -1; return; }
        if (hipFuncSetAttribute((const void*)mk_fwd, hipFuncAttributeMaxDynamicSharedMemorySize, LDS_BYTES) != hipSuccess) { fprintf(stderr, "kernel_launch: hipFuncSetAttribute failed\n"); grid = -1; return; }
        (void)hipGetLastError();
        grid = cus;
    }
    if (grid < 0) return;
    (void)hipMemsetAsync((char*)d_ws + WS_CTL, 0, CTL_ZERO_BYTES, stream);
    Args a{};
    for (int i = 0; i < 20; ++i) a.in[i] = (const float*)d_in[i];
    a.out = (float*)d_out; a.ws = (unsigned char*)d_ws;
#if N_LAUNCH_MODE == 1
    a.ph_lo = 0; a.ph_hi = NPHASE; a.li = 0;
    hipLaunchKernelGGL(mk_fwd, dim3(grid), dim3(NWAVES * 64), LDS_BYTES, stream, a);
#else
    for (int ph = 0; ph < NPHASE; ++ph) {
        a.ph_lo = ph; a.ph_hi = ph + 1; a.li = 0;
        hipLaunchKernelGGL(mk_fwd, dim3(grid), dim3(NWAVES * 64), LDS_BYTES, stream, a);
    }
#endif
}
```
